# Optimizing an MI355X kernel written in HIP

```python
import math
import jax, jax.numpy as jnp
from jax import lax
import numpy as np

D_MODEL = 2048
BATCH = 4
SEQ = 2048
DEPTH = 4

D_MIX = D_MODEL
D_MLSTM = D_MIX // 2
D_MOBA = D_MIX - D_MLSTM
MLSTM_HEADS = 4
MLSTM_HD = D_MLSTM // MLSTM_HEADS
MLSTM_CHUNK = 64
MLSTM_CONV = 4
MOBA_HEADS = 8
MOBA_HD = D_MOBA // MOBA_HEADS
MOBA_BLOCK = 256
MOBA_TOPK = 3
MOBA_QCHUNK = 32
N_BUCKETS = 32
MAX_DISTANCE = 2048
D_FF = 5632
FFN_CONV = 3
EPS = 1e-6
D_IN = 4 * D_MLSTM + 2 * MLSTM_HEADS + 3 * D_MOBA
MIX_SPLITS = (D_MLSTM, 2 * D_MLSTM, 3 * D_MLSTM, 4 * D_MLSTM,
              4 * D_MLSTM + MLSTM_HEADS, 4 * D_MLSTM + 2 * MLSTM_HEADS,
              4 * D_MLSTM + 2 * MLSTM_HEADS + D_MOBA, 4 * D_MLSTM + 2 * MLSTM_HEADS + 2 * D_MOBA)

kernel_name = "hybrid_mlstm_moba_convffn"


def rms_norm(x, g):
    xf = x.astype(jnp.float32)
    y = xf * lax.rsqrt(jnp.mean(xf * xf, axis=-1, keepdims=True) + EPS)
    return (y * g.astype(jnp.float32)).astype(x.dtype)


def causal_dwconv(x, w, b):
    K = w.shape[0]
    S = x.shape[1]
    xp = jnp.pad(x, ((0, 0), (K - 1, 0), (0, 0)))
    y = b
    for j in range(K):
        y = y + w[j] * xp[:, j:j + S]
    return y


def split_heads(t, n_heads):
    B, S, _ = t.shape
    return t.reshape(B, S, n_heads, -1).transpose(0, 2, 1, 3)


def merge_heads(t):
    B, H, S, dh = t.shape
    return t.transpose(0, 2, 1, 3).reshape(B, S, H * dh)


def t5_bucket(dist):
    max_exact = N_BUCKETS // 2
    d = jnp.maximum(dist, 0)
    ratio = jnp.maximum(d, max_exact).astype(jnp.float32) / max_exact
    large = max_exact + (jnp.log(ratio) / math.log(MAX_DISTANCE / max_exact)
                         * (N_BUCKETS - max_exact)).astype(jnp.int32)
    return jnp.where(d < max_exact, d, jnp.minimum(large, N_BUCKETS - 1))


def mlstm_chunkwise(q, k, v, log_i, log_f):
    B, H, S, dh = q.shape
    L = MLSTM_CHUNK
    nc = S // L
    f32 = jnp.float32

    def chunks(t):
        return jnp.moveaxis(t.astype(f32).reshape(B, H, nc, L, *t.shape[3:]), 2, 0)

    qc = chunks(q) * (dh ** -0.5)
    kc, vc, lic, lfc = chunks(k), chunks(v), chunks(log_i), chunks(log_f)
    causal = jnp.tril(jnp.ones((L, L), dtype=bool))

    def step(carry, inp):
        C, n, m = carry
        qt, kt, vt, li, lf = inp
        b = jnp.cumsum(lf, axis=-1)
        D = b[..., :, None] - b[..., None, :] + li[..., None, :]
        D = jnp.where(causal, D, -jnp.inf)
        inter = b + m[..., None]
        m_t = jnp.maximum(inter, jnp.max(D, axis=-1))
        w_inter = jnp.exp(inter - m_t)
        s = jnp.einsum('bhtd,bhsd->bhts', qt, kt) * jnp.exp(D - m_t[..., None])
        num = (w_inter[..., None] * jnp.einsum('bhtd,bhde->bhte', qt, C)
               + jnp.einsum('bhts,bhse->bhte', s, vt))
        den = w_inter * jnp.einsum('bhtd,bhd->bht', qt, n) + jnp.sum(s, axis=-1)
        h = num / jnp.maximum(jnp.abs(den), jnp.exp(-m_t))[..., None]
        bL = b[..., -1]
        g = bL[..., None] - b + li
        m_new = jnp.maximum(bL + m, jnp.max(g, axis=-1))
        a = jnp.exp(bL + m - m_new)
        wk = jnp.exp(g - m_new[..., None])
        C = a[..., None, None] * C + jnp.einsum('bhs,bhsd,bhse->bhde', wk, kt, vt)
        n = a[..., None] * n + jnp.einsum('bhs,bhsd->bhd', wk, kt)
        return (C, n, m_new), h

    init = (jnp.zeros((B, H, dh, dh), f32), jnp.zeros((B, H, dh), f32), jnp.zeros((B, H), f32))
    _, h = lax.scan(step, init, (qc, kc, vc, lic, lfc))
    h = jnp.moveaxis(h, 0, 2).reshape(B, H, S, dh)
    return h.astype(q.dtype)


def moba_attention(q, k, v, rel_bias):
    B, H, S, dh = q.shape
    f32 = jnp.float32
    nb = -(-S // MOBA_BLOCK)
    sp = nb * MOBA_BLOCK
    pad = ((0, 0), (0, 0), (0, sp - S), (0, 0))
    q, k, v = jnp.pad(q, pad), jnp.pad(k, pad), jnp.pad(v, pad)
    kb = k.reshape(B, H, nb, MOBA_BLOCK, dh)
    vb = v.reshape(B, H, nb, MOBA_BLOCK, dh)
    k_mean = jnp.mean(kb.astype(f32), axis=3)
    q_blk = jnp.arange(sp) // MOBA_BLOCK
    gate = jnp.einsum('bhsd,bhnd->bhsn', q.astype(f32), k_mean)
    past = jnp.arange(nb)[None, :] < q_blk[:, None]
    gate = jnp.where(past, gate, -jnp.inf)
    n_sel = min(MOBA_TOPK, nb)
    _, sel = lax.top_k(gate, n_sel)
    valid = sel < q_blk[:, None]
    nq = sp // MOBA_QCHUNK

    def to_chunks(t):
        return jnp.moveaxis(t.reshape(B, H, nq, MOBA_QCHUNK, *t.shape[3:]), 2, 0)

    bias_t = rel_bias.astype(f32).T
    b_idx = jnp.arange(B)[:, None, None, None]
    h_idx = jnp.arange(H)[None, :, None, None]
    offs = jnp.arange(MOBA_BLOCK)
    scale = dh ** -0.5
    n_cat = n_sel * MOBA_BLOCK

    def one_chunk(args):
        qc, selc, validc, c = args
        q_pos = c * MOBA_QCHUNK + jnp.arange(MOBA_QCHUNK)
        k_sel = kb[b_idx, h_idx, selc]
        v_sel = vb[b_idx, h_idx, selc]
        s_sel = jnp.einsum('bhqd,bhqnkd->bhqnk', qc, k_sel, preferred_element_type=f32) * scale
        k_pos = selc[..., None] * MOBA_BLOCK + offs
        s_sel = s_sel + bias_t[h_idx[..., None], t5_bucket(q_pos[:, None, None] - k_pos)]
        s_sel = jnp.where(validc[..., None], s_sel, -jnp.inf).reshape(B, H, MOBA_QCHUNK, n_cat)
        own = (c * MOBA_QCHUNK) // MOBA_BLOCK
        k_own = lax.dynamic_index_in_dim(kb, own, axis=2, keepdims=False)
        v_own = lax.dynamic_index_in_dim(vb, own, axis=2, keepdims=False)
        rel = q_pos[:, None] - (own * MOBA_BLOCK + offs)[None, :]
        s_own = (jnp.einsum('bhqd,bhkd->bhqk', qc, k_own, preferred_element_type=f32) * scale
                 + bias_t[:, t5_bucket(rel)])
        s_own = jnp.where(rel >= 0, s_own, -jnp.inf)
        p = jax.nn.softmax(jnp.concatenate([s_sel, s_own], axis=-1), axis=-1).astype(v.dtype)
        p_sel = p[..., :n_cat].reshape(B, H, MOBA_QCHUNK, n_sel, MOBA_BLOCK)
        out = (jnp.einsum('bhqnk,bhqnkd->bhqd', p_sel, v_sel, preferred_element_type=f32)
               + jnp.einsum('bhqk,bhkd->bhqd', p[..., n_cat:], v_own, preferred_element_type=f32))
        return out.astype(q.dtype)

    out = lax.map(one_chunk, (to_chunks(q), to_chunks(sel), to_chunks(valid), jnp.arange(nq)))
    out = jnp.moveaxis(out, 0, 2).reshape(B, H, sp, dh)
    return out[:, :, :S]


def setup_inputs(seed: int = 0) -> dict:
    key = jax.random.key(seed)
    ks = jax.random.split(key, 18)

    def nrm(k, shape, scale):
        return jax.random.normal(k, shape, jnp.float32) * scale

    x = nrm(ks[0], (BATCH, SEQ, D_MODEL), 1.0)
    norm_mix = 1.0 + nrm(ks[1], (DEPTH, D_MODEL), 0.02)
    w_in = nrm(ks[2], (DEPTH, D_MODEL, D_IN), D_MODEL ** -0.5)
    gate_bias = jnp.concatenate(
        [nrm(ks[3], (DEPTH, MLSTM_HEADS), 0.1),
         jnp.linspace(3.0, 6.0, MLSTM_HEADS)[None, :] + nrm(ks[4], (DEPTH, MLSTM_HEADS), 0.1)], axis=-1)
    conv_qk_w = nrm(ks[5], (DEPTH, MLSTM_CONV, 2 * D_MLSTM), MLSTM_CONV ** -0.5)
    conv_qk_b = nrm(ks[6], (DEPTH, 2 * D_MLSTM), 0.02)
    mlstm_norm = 1.0 + nrm(ks[7], (DEPTH, MLSTM_HEADS, MLSTM_HD), 0.02)
    qk_norm = 1.0 + nrm(ks[8], (DEPTH, 2, MOBA_HD), 0.02)
    rel_bias = nrm(ks[9], (N_BUCKETS, MOBA_HEADS), 0.5)
    w_out = nrm(ks[10], (DEPTH, D_MIX, D_MODEL), D_MIX ** -0.5)
    norm_ffn = 1.0 + nrm(ks[11], (DEPTH, D_MODEL), 0.02)
    w_up = nrm(ks[12], (DEPTH, D_MODEL, 2 * D_FF), D_MODEL ** -0.5)
    conv_ffn_w = nrm(ks[13], (DEPTH, FFN_CONV, 2 * D_FF), FFN_CONV ** -0.5)
    conv_ffn_b = nrm(ks[14], (DEPTH, 2 * D_FF), 0.02)
    w_down = nrm(ks[15], (DEPTH, D_FF, D_MODEL), D_FF ** -0.5)
    return {"x": x, "norm_mix": norm_mix, "w_in": w_in, "gate_bias": gate_bias,
            "conv_qk_w": conv_qk_w, "conv_qk_b": conv_qk_b, "mlstm_norm": mlstm_norm,
            "qk_norm": qk_norm, "rel_bias": rel_bias, "w_out": w_out, "norm_ffn": norm_ffn,
            "w_up": w_up, "conv_ffn_w": conv_ffn_w, "conv_ffn_b": conv_ffn_b, "w_down": w_down}


def reference(x, norm_mix, w_in, gate_bias, conv_qk_w, conv_qk_b, mlstm_norm, qk_norm, rel_bias,
              w_out, norm_ffn, w_up, conv_ffn_w, conv_ffn_b, w_down):
    H = MLSTM_HEADS
    for l in range(DEPTH):
        h = rms_norm(x, norm_mix[l])
        z = jnp.einsum('bsd,de->bse', h, w_in[l])
        mq, mk, mv, mo, gi, gf, aq, ak, av = jnp.split(z, MIX_SPLITS, axis=-1)
        qk = jax.nn.silu(causal_dwconv(jnp.concatenate([mq, mk], axis=-1), conv_qk_w[l], conv_qk_b[l]))
        mq, mk = qk[..., :D_MLSTM], qk[..., D_MLSTM:]
        gates = jnp.concatenate([gi, gf], axis=-1).astype(jnp.float32) + gate_bias[l]
        log_i = gates[..., :H].transpose(0, 2, 1)
        log_f = jax.nn.log_sigmoid(gates[..., H:]).transpose(0, 2, 1)
        hm = mlstm_chunkwise(split_heads(mq, H), split_heads(mk, H), split_heads(mv, H), log_i, log_f)
        hm = rms_norm(hm, mlstm_norm[l][:, None, :])
        hm = merge_heads(hm) * jax.nn.sigmoid(mo)
        aqh = rms_norm(split_heads(aq, MOBA_HEADS), qk_norm[l, 0])
        akh = rms_norm(split_heads(ak, MOBA_HEADS), qk_norm[l, 1])
        ha = merge_heads(moba_attention(aqh, akh, split_heads(av, MOBA_HEADS), rel_bias))
        x = x + jnp.einsum('bse,ed->bsd', jnp.concatenate([hm, ha], axis=-1), w_out[l])
        h = rms_norm(x, norm_ffn[l])
        u = causal_dwconv(jnp.einsum('bsd,df->bsf', h, w_up[l]), conv_ffn_w[l], conv_ffn_b[l])
        g, val = u[..., :D_FF], u[..., D_FF:]
        x = x + jnp.einsum('bsf,fd->bsd', jax.nn.silu(g) * val, w_down[l])
    return x
```

```cpp
#include <hip/hip_runtime.h>
#include <hip/hip_cooperative_groups.h>
#include <cstdio>
#include <cmath>
namespace cg = cooperative_groups;
__device__ __forceinline__ int otid() { int t; asm volatile("v_mov_b32 %0, %1" : "=v"(t) : "v"((int)threadIdx.x)); return t; }
namespace pg8 {
#define PG8_LAS __attribute__((address_space(3)))
typedef unsigned short bf16_t;
typedef short bf16x8 __attribute__((ext_vector_type(8)));
typedef float f32x4 __attribute__((ext_vector_type(4)));
typedef unsigned u32x4 __attribute__((ext_vector_type(4)));
constexpr int BM = 256, BK = 64, HALF = 128, HTB = HALF * BK * 2  , STAGE_BYTES = 8 * HTB, NXCD = 8, WGM = 8;

__host__ __device__ __forceinline__ int lds_byte(int r, int c) { const int st = (r >> 4) * 2 + (c >> 5), rr = r & 15, cc = c & 31, ob = rr * 64 + cc * 2; return st * 1024 + (ob ^ (((ob >> 9) & 1) << 5)); }
__host__ __device__ __forceinline__ void stage_rc(int b, int& R, int& C) { const int st = b / 1024, sb = b % 1024, swz = sb ^ (((sb >> 9) & 1) << 5); R = (st >> 1) * 16 + swz / 64; C = (st & 1) * 32 + (swz % 64) / 2; }
__host__ __device__ __forceinline__ int perm32(int rho) { const int n = rho >> 4, i = rho & 15; return 8 * (i >> 2) + 4 * n + (i & 3); }

struct Unit { int pm, pn; };
struct Gemm { const bf16_t* A; const bf16_t* Bt; int M, N, K; };

struct StaticOrder {
    int nM, nN, nwg, G, c;
    __host__ __device__ void init(int M, int N, int G_, int c_) { nM = M / BM; nN = N / BM; nwg = nM * nN; G = G_; c = c_; }
    __host__ __device__ bool next(int i, Unit& u) const {
        const long L = (long)i * G + c; if (L >= nwg) return false;
        int wgid = (int)L; { const int q = nwg / NXCD, r = nwg % NXCD, xcd = wgid % NXCD, off = wgid / NXCD; wgid = (xcd < r ? xcd * (q + 1) : r * (q + 1) + (xcd - r) * q) + off; }
        const int nig = WGM * nN, gid = wgid / nig, fm = gid * WGM, gsz = (nM - fm) < WGM ? (nM - fm) : WGM;
        u.pm = fm + ((wgid % nig) % gsz); u.pn = (wgid % nig) / gsz; return true;
    }
    __device__ __forceinline__ void a_ready(const Unit&) const {}
    __device__ __forceinline__ void done(const Unit&) const {}
};

__device__ __forceinline__ unsigned cvt_pk_bf16(float lo, float hi) { unsigned r; asm volatile("v_cvt_pk_bf16_f32 %0, %1, %2" : "=v"(r) : "v"(lo), "v"(hi)); return r; }

template <class Epi, class Sched, bool STAMP = false>
__device__ __forceinline__ void gemm_phase(PG8_LAS unsigned char* lds, const Gemm g, const Sched& S, const Epi& E, unsigned long long* stamps) {
    const int tid = otid(), wid = __builtin_amdgcn_readfirstlane(tid >> 6), lane = tid & 63, wr = wid >> 2, wc = wid & 3, fr = lane & 15, fq = lane >> 4;
    const int K = g.K, nt = K / BK;
    int ts_lo = 0, ts_hi = 0, nts = 0; const unsigned long long rt_entry = STAMP ? (unsigned long long)wall_clock64() : 0ull;
#define PG8_STAMP() do { if (STAMP && wid == 0 && nts < 64) { const unsigned long long _c = (unsigned long long)clock64(); \
        ts_lo = (lane == nts) ? (int)(unsigned)_c : ts_lo; ts_hi = (lane == nts) ? (int)(unsigned)(_c >> 32) : ts_hi; ++nts; } } while (0)
    PG8_STAMP();
    unsigned voffA[2], voffB[2];
#pragma unroll
    for (int i = 0; i < 2; ++i) { int R, C; stage_rc(tid * 16 + i * 8192, R, C); const int Rb = Epi::PERM ? ((R & ~31) + perm32(R & 31)) : R;
        voffA[i] = (unsigned)(R * K + C) * 2u; voffB[i] = (unsigned)(Rb * K + C) * 2u; }
    const size_t kstep = (size_t)(BK * 2);
    const size_t hstep = (size_t)HALF * K * 2;
    const size_t tstep = 2 * hstep;
    const unsigned ldsw = (unsigned)wid * 1024u;
    const int aoff = lds_byte(wr * 64 + fr, fq * 8), boff = lds_byte(wc * 32 + fr, fq * 8);
#define PG8_SA(b, h) (((b) * 2 + (h)) * HTB)
#define PG8_SB(b, h) ((4 + (b) * 2 + (h)) * HTB)
#define PG8_STAGE(bufoff, gbase, voff) do { _Pragma("unroll") for (int _i = 0; _i < 2; ++_i) \
        __builtin_amdgcn_global_load_lds((const unsigned*)((const char*)(gbase) + (voff)[_i]), (PG8_LAS unsigned*)(lds + (bufoff) + ldsw + _i * 8192), 16, 0, 0); } while (0)
#define PG8_LDA(dst, b, h) do { _Pragma("unroll") for (int m = 0; m < 4; ++m) _Pragma("unroll") for (int k = 0; k < 2; ++k) dst[m][k] = *(const PG8_LAS bf16x8*)(lds + PG8_SA(b, h) + aoff + m * 2048 + k * 1024); } while (0)
#define PG8_LDB(dst, b, h) do { _Pragma("unroll") for (int n = 0; n < 2; ++n) _Pragma("unroll") for (int k = 0; k < 2; ++k) dst[n][k] = *(const PG8_LAS bf16x8*)(lds + PG8_SB(b, h) + boff + n * 2048 + k * 1024); } while (0)
#define PG8_MMA(ai, bj, At, Bt) do { __builtin_amdgcn_s_setprio(1); _Pragma("unroll") for (int m = 0; m < 4; ++m) _Pragma("unroll") for (int n = 0; n < 2; ++n) _Pragma("unroll") for (int k = 0; k < 2; ++k) \
        acc[ai][bj][m][n] = __builtin_amdgcn_mfma_f32_16x16x32_bf16(Bt[n][k], At[m][k], acc[ai][bj][m][n], 0, 0, 0); __builtin_amdgcn_s_setprio(0); } while (0)
#define PG8_WAIT_V(n) asm volatile("s_waitcnt vmcnt(" #n ")" ::: "memory")
#define PG8_WAIT_L(n) asm volatile("s_waitcnt lgkmcnt(" #n ")" ::: "memory")
#define PG8_BAR __builtin_amdgcn_s_barrier()
#define PG8_SCHED __builtin_amdgcn_sched_barrier(0)
    Unit cur, nxt; int ui = 0;
    if (!S.next(0, cur)) return;
    f32x4 acc[2][2][4][2];
#pragma unroll
    for (int a = 0; a < 2; ++a)
#pragma unroll
        for (int b = 0; b < 2; ++b)
#pragma unroll
            for (int m = 0; m < 4; ++m)
#pragma unroll
                for (int n = 0; n < 2; ++n) acc[a][b][m][n] = (f32x4){0.f, 0.f, 0.f, 0.f};
    bf16x8 At[4][2], B0[2][2], B1[2][2];
    const char* cA = (const char*)g.A + (size_t)cur.pm * tstep; const char* cB = (const char*)g.Bt + (size_t)cur.pn * tstep;
    S.a_ready(cur);
    PG8_STAGE(PG8_SB(0, 0), cB, voffB); PG8_STAGE(PG8_SA(0, 0), cA, voffA); PG8_STAGE(PG8_SB(0, 1), cB + hstep, voffB); PG8_STAGE(PG8_SA(0, 1), cA + hstep, voffA);
    if (wr == 1) PG8_BAR;
    PG8_WAIT_V(4); PG8_BAR;
    PG8_STAGE(PG8_SB(1, 0), cB + kstep, voffB); PG8_STAGE(PG8_SA(1, 0), cA + kstep, voffA); PG8_STAGE(PG8_SB(1, 1), cB + hstep + kstep, voffB);
    PG8_WAIT_V(6); PG8_BAR;
    PG8_STAMP();
    for (;;) {
        const bool has_next = S.next(ui + 1, nxt);
        const char* nA = has_next ? (const char*)g.A + (size_t)nxt.pm * tstep : cA; const char* nB = has_next ? (const char*)g.Bt + (size_t)nxt.pn * tstep : cB;
        for (int t = 0; t < nt; t += 2) {
            const bool last = (t == nt - 2);
            const char* a1 = cA + (size_t)(t + 1) * kstep;
            const char* a2 = last ? nA : cA + (size_t)(t + 2) * kstep; const char* b2 = last ? nB : cB + (size_t)(t + 2) * kstep;
            const char* a3 = a2 + kstep; const char* b3 = b2 + kstep;
            if (last && has_next) S.a_ready(nxt);
            PG8_LDB(B0, 0, 0); PG8_SCHED; PG8_LDA(At, 0, 0); PG8_STAGE(PG8_SA(1, 1), a1 + hstep, voffA);
            PG8_WAIT_L(8); PG8_BAR; PG8_WAIT_L(0); PG8_MMA(0, 0, At, B0); PG8_BAR; PG8_SCHED;
            PG8_LDB(B1, 0, 1); PG8_STAGE(PG8_SB(0, 0), b2, voffB);
            PG8_BAR; PG8_WAIT_L(0); PG8_MMA(0, 1, At, B1); PG8_BAR;
            PG8_LDA(At, 0, 1); PG8_STAGE(PG8_SA(0, 0), a2, voffA);
            PG8_BAR; PG8_WAIT_L(0); PG8_MMA(1, 0, At, B0); PG8_BAR; PG8_SCHED;
            PG8_STAGE(PG8_SB(0, 1), b2 + hstep, voffB);
            PG8_WAIT_V(6); PG8_BAR; PG8_MMA(1, 1, At, B1); PG8_BAR;
            PG8_LDB(B0, 1, 0); PG8_SCHED; PG8_LDA(At, 1, 0); PG8_STAGE(PG8_SA(0, 1), a2 + hstep, voffA);
            PG8_WAIT_L(8); PG8_BAR; PG8_WAIT_L(0); PG8_MMA(0, 0, At, B0); PG8_BAR; PG8_SCHED;
            PG8_LDB(B1, 1, 1); PG8_STAGE(PG8_SB(1, 0), b3, voffB);
            PG8_BAR; PG8_WAIT_L(0); PG8_MMA(0, 1, At, B1); PG8_BAR;
            PG8_LDA(At, 1, 1); PG8_STAGE(PG8_SA(1, 0), a3, voffA);
            PG8_BAR; PG8_WAIT_L(0); PG8_MMA(1, 0, At, B0); PG8_BAR; PG8_SCHED;
            PG8_STAGE(PG8_SB(1, 1), b3 + hstep, voffB);
            PG8_WAIT_V(6); PG8_BAR; PG8_MMA(1, 1, At, B1); PG8_BAR;
        }
        PG8_STAMP();
        if constexpr (!Epi::AFTER_DRAIN) { E(acc, cur, wr, wc, fr, fq); S.done(cur); }
        PG8_STAMP();
        if (!has_next) break;
#pragma unroll
        for (int a = 0; a < 2; ++a)
#pragma unroll
            for (int b = 0; b < 2; ++b)
#pragma unroll
                for (int m = 0; m < 4; ++m)
#pragma unroll
                    for (int n = 0; n < 2; ++n) acc[a][b][m][n] = (f32x4){0.f, 0.f, 0.f, 0.f};
        cur = nxt; cA = nA; cB = nB; ++ui;
    }
    PG8_WAIT_V(0);
    if (wr == 0) PG8_BAR;
    PG8_BAR;
    if constexpr (Epi::AFTER_DRAIN) { E.fused(acc, cur, wr, wc, fr, fq, lds, wid, lane); S.done(cur); }
    PG8_STAMP();
    if (STAMP && wid == 0) { stamps[lane] = lane < nts ? (((unsigned long long)(unsigned)ts_hi << 32) | (unsigned)ts_lo) : 0ull;
        if (lane == 62) stamps[62] = rt_entry; if (lane == 63) stamps[63] = (unsigned long long)wall_clock64(); }
#undef PG8_STAMP
#undef PG8_SA
#undef PG8_SB
#undef PG8_STAGE
#undef PG8_LDA
#undef PG8_LDB
#undef PG8_MMA
#undef PG8_WAIT_V
#undef PG8_WAIT_L
#undef PG8_BAR
#undef PG8_SCHED
}
}

using pg8::bf16_t; using pg8::bf16x8; using pg8::f32x4; using pg8::u32x4;
typedef unsigned u32x2 __attribute__((ext_vector_type(2)));
#define LAS __attribute__((address_space(3)))
#define DI __device__ __forceinline__
#define MFMA16(a, b, c) __builtin_amdgcn_mfma_f32_16x16x32_bf16((a), (b), (c), 0, 0, 0)

constexpr int T_TOK = 8192, DM = 2048, SEQ = 2048, DEPTH = 4;
constexpr int DIN_SRC = 7176, DINP = 7424, ZLD = 7168, DFF = 5632, DFF2 = 11264;
constexpr int LDS_BYTES = 147456;
constexpr float EPS = 1e-6f;

constexpr size_t al256(size_t x) { return (x + 255) & ~(size_t)255; }
constexpr size_t SZ_WIN = (size_t)DINP * DM * 2, SZ_WOUT = (size_t)DM * DM * 2, SZ_WUP = (size_t)DFF2 * DM * 2, SZ_WD = (size_t)DM * DFF * 2;
constexpr size_t O_WIN = 0;
constexpr size_t O_WOUT = O_WIN + 4 * SZ_WIN;
constexpr size_t O_WUP = O_WOUT + 4 * SZ_WOUT;
constexpr size_t O_WD = O_WUP + 4 * SZ_WUP;
constexpr size_t O_XB = O_WD + 4 * SZ_WD;
constexpr size_t O_Z = O_XB + (size_t)T_TOK * DM * 2;
constexpr size_t O_GATES = O_Z + (size_t)T_TOK * ZLD * 2;
constexpr size_t O_QC = O_GATES + (size_t)T_TOK * 8 * 4;
constexpr size_t O_KC = O_QC + (size_t)T_TOK * 1024 * 2;
constexpr size_t O_KT = O_KC + (size_t)T_TOK * 1024 * 2;
constexpr size_t O_VT = O_KT + (size_t)T_TOK * 1024 * 2;
constexpr size_t O_GSC = O_VT + (size_t)T_TOK * 1024 * 2;
constexpr size_t O_ACH = O_GSC + (size_t)5 * 16 * 2048 * 4;
constexpr size_t O_AQN = O_ACH + 4096;
constexpr size_t O_AKN = O_AQN + (size_t)T_TOK * 1024 * 2;
constexpr size_t O_AVT = O_AKN + (size_t)T_TOK * 1024 * 2;
constexpr size_t O_KMEAN = O_AVT + (size_t)T_TOK * 1024 * 2;
constexpr size_t O_HBUF = O_KMEAN + (size_t)32 * 8 * 128 * 4;
constexpr size_t O_HSS = O_HBUF + (size_t)T_TOK * 1024 * 4;
constexpr size_t O_MIX = O_HSS + (size_t)T_TOK * 4 * 8;
constexpr size_t O_U = O_MIX + (size_t)T_TOK * DM * 2;
constexpr size_t O_ACT = O_U + (size_t)T_TOK * DFF2 * 2;
constexpr size_t O_SS = O_ACT + (size_t)T_TOK * DFF * 2;
constexpr size_t O_BIAST = O_SS + (size_t)9 * T_TOK * 8;
constexpr size_t WS_END = O_BIAST + (size_t)8 * 2048 * 4;

struct Args {
    const float* x; const float* norm_mix; const float* w_in; const float* gate_bias; const float* conv_qk_w; const float* conv_qk_b;
    const float* mlstm_norm; const float* qk_norm; const float* rel_bias; const float* w_out; const float* norm_ffn; const float* w_up;
    const float* conv_ffn_w; const float* conv_ffn_b; const float* w_down;
    float* out; unsigned char* ws;
};

DI unsigned f2bf(float f) { unsigned u = __builtin_bit_cast(unsigned, f); return (u + 0x7fffu + ((u >> 16) & 1u)) >> 16; }
DI unsigned pk2(float lo, float hi) { return f2bf(lo) | (f2bf(hi) << 16); }
DI float bflo(unsigned w) { return __builtin_bit_cast(float, w << 16); }
DI float bfhi(unsigned w) { return __builtin_bit_cast(float, w & 0xffff0000u); }
DI float bf1(bf16_t b) { return __builtin_bit_cast(float, ((unsigned)b) << 16); }
DI void unpack8(const u32x4 v, float (&f)[8]) { f[0] = bflo(v.x); f[1] = bfhi(v.x); f[2] = bflo(v.y); f[3] = bfhi(v.y); f[4] = bflo(v.z); f[5] = bfhi(v.z); f[6] = bflo(v.w); f[7] = bfhi(v.w); }
DI u32x4 pack8(const float (&f)[8]) { u32x4 r; r.x = pk2(f[0], f[1]); r.y = pk2(f[2], f[3]); r.z = pk2(f[4], f[5]); r.w = pk2(f[6], f[7]); return r; }
typedef unsigned long long u64;
constexpr float SS_SCALE = 268435456.0f, SS_INV = 1.0f / 268435456.0f;
constexpr float HS_SCALE = 4294967296.0f, HS_INV = 1.0f / 4294967296.0f;
DI u64 to_fix(float v, float scale) { return (u64)(v * scale + 0.5f); }
DI float sigmoidf_(float x) { return 1.0f / (1.0f + __expf(-x)); }
DI float siluf_(float x) { return x / (1.0f + __expf(-x)); }

struct EpiScale {
    static constexpr bool PERM = true, AFTER_DRAIN = false;
    bf16_t* O; int ldc; const u64* SS; float* gates; int gate_pn;
    DI void operator()(const f32x4 (&acc)[2][2][4][2], const pg8::Unit& u, int wr, int wc, int fr, int fq) const {
        const int row0 = u.pm * 256 + wr * 64 + fr, col0 = u.pn * 256 + wc * 32 + 8 * fq;
#pragma unroll
        for (int ai = 0; ai < 2; ++ai)
#pragma unroll
            for (int m = 0; m < 4; ++m) {
                const int r = row0 + ai * 128 + m * 16;
                const float rstd = rsqrtf((float)SS[r] * (SS_INV / 2048.0f) + EPS);
                if (u.pn == gate_pn) {
                    if (wc == 0 && fq == 0) { *(f32x4*)(gates + (size_t)r * 8) = acc[ai][0][m][0] * rstd; *(f32x4*)(gates + (size_t)r * 8 + 4) = acc[ai][0][m][1] * rstd; }
                } else {
                    bf16_t* rowp = O + (size_t)r * ldc + col0;
#pragma unroll
                    for (int bj = 0; bj < 2; ++bj) { const f32x4 v0 = acc[ai][bj][m][0] * rstd, v1 = acc[ai][bj][m][1] * rstd;
                        u32x4 w; w.x = pk2(v0[0], v0[1]); w.y = pk2(v0[2], v0[3]); w.z = pk2(v1[0], v1[1]); w.w = pk2(v1[2], v1[3]);
                        *(u32x4*)(rowp + bj * 128) = w; }
                }
            }
    }
};
struct EpiRes {
    static constexpr bool PERM = false, AFTER_DRAIN = false;
    float* X; bf16_t* XB; u64* SS;
    DI void operator()(const f32x4 (&acc)[2][2][4][2], const pg8::Unit& u, int wr, int wc, int fr, int fq) const {
        const int row0 = u.pm * 256 + wr * 64 + fr, col0 = u.pn * 256 + wc * 32 + 4 * fq;
#pragma unroll
        for (int ai = 0; ai < 2; ++ai)
#pragma unroll
            for (int m = 0; m < 4; ++m) {
                const int r = row0 + ai * 128 + m * 16;
                float* xp = X + (size_t)r * DM + col0; bf16_t* bp = XB + (size_t)r * DM + col0; float ssq = 0.f;
#pragma unroll
                for (int bj = 0; bj < 2; ++bj)
#pragma unroll
                    for (int n = 0; n < 2; ++n) { f32x4 v = *(const f32x4*)(xp + bj * 128 + n * 16) + acc[ai][bj][m][n];
                        *(f32x4*)(xp + bj * 128 + n * 16) = v; ssq += v[0] * v[0] + v[1] * v[1] + v[2] * v[2] + v[3] * v[3];
                        u32x2 p; p.x = pk2(v[0], v[1]); p.y = pk2(v[2], v[3]); *(u32x2*)(bp + bj * 128 + n * 16) = p; }
                ssq += __shfl_xor(ssq, 16); ssq += __shfl_xor(ssq, 32);
                if (fq == 0) atomicAdd(SS + r, to_fix(ssq, SS_SCALE));
            }
    }
};

template <class Epi> DI void run_gemm(unsigned char* smem, const bf16_t* A, const bf16_t* Bt, int M, int N, int K, const Epi& E) {
    pg8::Gemm g; g.A = A; g.Bt = Bt; g.M = M; g.N = N; g.K = K;
    pg8::StaticOrder S; S.init(M, N, (int)gridDim.x, (int)blockIdx.x);
    pg8::gemm_phase<Epi, pg8::StaticOrder, false>((PG8_LAS unsigned char*)smem, g, S, E, nullptr);
}

DI void transpose_tile(const float* src, int ldsrc, int sc, int nvalid, int k0, const float* g, bf16_t* dst, int ldd, int n0, float* tile) {
    const int tid = otid();
#pragma unroll
    for (int i = 0; i < 2; ++i) {
        const int kk = (tid >> 4) + 32 * i, c4 = (tid & 15) * 4;
        f32x4 v = {0.f, 0.f, 0.f, 0.f};
        if (c4 < nvalid) { v = *(const f32x4*)(src + (size_t)(k0 + kk) * ldsrc + sc + c4); if (g) v = v * g[k0 + kk]; }
        float* tp = tile + kk * 65 + c4; tp[0] = v[0]; tp[1] = v[1]; tp[2] = v[2]; tp[3] = v[3];
    }
    __syncthreads();
    { const int n = tid >> 3, k8 = (tid & 7) * 8; float f[8];
#pragma unroll
      for (int j = 0; j < 8; ++j) f[j] = tile[(k8 + j) * 65 + n];
      *(u32x4*)(dst + (size_t)(n0 + n) * ldd + k0 + k8) = pack8(f); }
    __syncthreads();
}

DI int t5_bucket(int d) {
    if (d < 16) return d;
    const float ratio = (float)d / 16.0f;
    int large = 16 + (int)(logf(ratio) / 4.852030263919617f * 16.0f);
    return large < 31 ? large : 31;
}

DI void phase0(const Args& a, unsigned char* smem) {
    float* tile = (float*)smem;
    const int tid = otid();
    constexpr int PER_LAYER = 116 * 32 + 32 * 32 + 176 * 32 + 32 * 88;
    constexpr int NTILES = 4 * PER_LAYER, NX = 1024;
    for (int it = blockIdx.x; it < NTILES + NX; it += gridDim.x) {
        if (it < NTILES) {
            const int l = it / PER_LAYER; int r = it % PER_LAYER;
            if (r < 116 * 32) {
                const int kt = r / 116, nt = r % 116; int sc, nv;
                if (nt < 64) { sc = nt * 64; nv = 64; } else if (nt < 112) { sc = nt * 64 + 8; nv = 64; } else if (nt == 112) { sc = 4096; nv = 8; } else { sc = 0; nv = 0; }
                transpose_tile(a.w_in + (size_t)l * DM * DIN_SRC, DIN_SRC, sc, nv, kt * 64, a.norm_mix + l * DM, (bf16_t*)(a.ws + O_WIN + l * SZ_WIN), DM, nt * 64, tile);
            } else if ((r -= 116 * 32) < 32 * 32) {
                const int kt = r / 32, nt = r % 32;
                transpose_tile(a.w_out + (size_t)l * DM * DM, DM, nt * 64, 64, kt * 64, nullptr, (bf16_t*)(a.ws + O_WOUT + l * SZ_WOUT), DM, nt * 64, tile);
            } else if ((r -= 32 * 32) < 176 * 32) {
                const int kt = r / 176, nt = r % 176;
                transpose_tile(a.w_up + (size_t)l * DM * DFF2, DFF2, nt * 64, 64, kt * 64, a.norm_ffn + l * DM, (bf16_t*)(a.ws + O_WUP + l * SZ_WUP), DM, nt * 64, tile);
            } else {
                r -= 176 * 32; const int kt = r / 32, nt = r % 32;
                transpose_tile(a.w_down + (size_t)l * DFF * DM, DM, nt * 64, 64, kt * 64, nullptr, (bf16_t*)(a.ws + O_WD + l * SZ_WD), DFF, nt * 64, tile);
            }
        } else {
            const int row = (it - NTILES) * 8 + (tid >> 6), lane = tid & 63;
            const float* xp = a.x + (size_t)row * DM; float* op = a.out + (size_t)row * DM; bf16_t* bp = (bf16_t*)(a.ws + O_XB) + (size_t)row * DM;
            float ssq = 0.f;
#pragma unroll
            for (int i = 0; i < 8; ++i) { const int c = (i * 64 + lane) * 4; const f32x4 v = *(const f32x4*)(xp + c); *(f32x4*)(op + c) = v;
                ssq += v[0] * v[0] + v[1] * v[1] + v[2] * v[2] + v[3] * v[3]; u32x2 p; p.x = pk2(v[0], v[1]); p.y = pk2(v[2], v[3]); *(u32x2*)(bp + c) = p; }
#pragma unroll
            for (int o = 1; o < 64; o <<= 1) ssq += __shfl_xor(ssq, o);
            if (lane == 0) ((u64*)(a.ws + O_SS))[row] = to_fix(ssq, SS_SCALE);
        }
    }
    const int gt = blockIdx.x * 512 + tid, gn = gridDim.x * 512;
    u64* ss = (u64*)(a.ws + O_SS);
    for (int i = gt; i < 8 * T_TOK; i += gn) ss[T_TOK + i] = 0ull;
    float* bt = (float*)(a.ws + O_BIAST);
    for (int i = gt; i < 8 * 2048; i += gn) { const int h = i >> 11, d = i & 2047; bt[i] = a.rel_bias[t5_bucket(d) * 8 + h]; }
}

DI void prep_mlstm_item(const Args& a, int l, int item, unsigned char* smem) {
    const int bh = item >> 5, c = item & 31, b = bh >> 2, h = bh & 3, tid = otid();
    const bf16_t* z = (const bf16_t*)(a.ws + O_Z);
    bf16_t* tile = (bf16_t*)smem;
    const int cg8 = tid & 31, rg = tid >> 5;
    const size_t trow0 = (size_t)b * SEQ + c * 64;
#pragma unroll 1
    for (int part = 0; part < 2; ++part) {
        const int ch0 = part * 1024 + h * 256 + cg8 * 8;
        const float* cw = a.conv_qk_w + (size_t)l * 4 * 2048 + ch0; const float* cb = a.conv_qk_b + (size_t)l * 2048 + ch0;
        float w[4][8], bias[8], xin[7][8];
#pragma unroll
        for (int j = 0; j < 4; ++j) { const f32x4 w0 = *(const f32x4*)(cw + j * 2048), w1 = *(const f32x4*)(cw + j * 2048 + 4);
            w[j][0] = w0[0]; w[j][1] = w0[1]; w[j][2] = w0[2]; w[j][3] = w0[3]; w[j][4] = w1[0]; w[j][5] = w1[1]; w[j][6] = w1[2]; w[j][7] = w1[3]; }
        { const f32x4 b0 = *(const f32x4*)cb, b1 = *(const f32x4*)(cb + 4); bias[0] = b0[0]; bias[1] = b0[1]; bias[2] = b0[2]; bias[3] = b0[3]; bias[4] = b1[0]; bias[5] = b1[1]; bias[6] = b1[2]; bias[7] = b1[3]; }
#pragma unroll
        for (int i = 0; i < 7; ++i) { const int sl = c * 64 + rg * 4 - 3 + i;
            u32x4 v = {0u, 0u, 0u, 0u}; if (sl >= 0) v = *(const u32x4*)(z + ((size_t)b * SEQ + sl) * ZLD + ch0);
            unpack8(v, xin[i]); }
        bf16_t* dst = (bf16_t*)(a.ws + (part == 0 ? O_QC : O_KC));
        const float osc = part == 0 ? 0.0625f : 1.0f;
#pragma unroll
        for (int o = 0; o < 4; ++o) { float y[8];
#pragma unroll
            for (int e = 0; e < 8; ++e) { float s = bias[e];
#pragma unroll
                for (int j = 0; j < 4; ++j) s += w[j][e] * xin[o + j][e];
                y[e] = siluf_(s) * osc; }
            const u32x4 pk = pack8(y);
            *(u32x4*)(dst + (trow0 + rg * 4 + o) * 1024 + h * 256 + cg8 * 8) = pk;
            if (part == 1) *(u32x4*)(tile + (rg * 4 + o) * 264 + cg8 * 8) = pk; }
    }
    __syncthreads();
    { const int d = tid >> 1, sh = tid & 1; bf16_t* kT = (bf16_t*)(a.ws + O_KT) + ((size_t)(bh * 32 + c) * 256 + d) * 64 + sh * 32;
#pragma unroll
      for (int i = 0; i < 4; ++i) { unsigned wv[4];
#pragma unroll
          for (int j = 0; j < 4; ++j) { const int s = sh * 32 + i * 8 + j * 2; wv[j] = (unsigned)tile[s * 264 + d] | ((unsigned)tile[(s + 1) * 264 + d] << 16); }
          u32x4 v; v.x = wv[0]; v.y = wv[1]; v.z = wv[2]; v.w = wv[3]; *(u32x4*)(kT + i * 8) = v; } }
    __syncthreads();
    { const int row = tid >> 3, seg = tid & 7;
#pragma unroll
      for (int i = 0; i < 4; ++i) { const int col = seg * 8 + i * 64; *(u32x4*)(tile + row * 264 + col) = *(const u32x4*)(z + (trow0 + row) * ZLD + 2048 + h * 256 + col); } }
    __syncthreads();
    { const int d = tid >> 1, sh = tid & 1; bf16_t* vT = (bf16_t*)(a.ws + O_VT) + ((size_t)(bh * 32 + c) * 256 + d) * 64 + sh * 32;
#pragma unroll
      for (int i = 0; i < 4; ++i) { unsigned wv[4];
#pragma unroll
          for (int j = 0; j < 4; ++j) { const int s = sh * 32 + i * 8 + j * 2; wv[j] = (unsigned)tile[s * 264 + d] | ((unsigned)tile[(s + 1) * 264 + d] << 16); }
          u32x4 v; v.x = wv[0]; v.y = wv[1]; v.z = wv[2]; v.w = wv[3]; *(u32x4*)(vT + i * 8) = v; } }
    __syncthreads();
}

DI void prep_attn_item(const Args& a, int l, int item, unsigned char* smem) {
    const int b = item >> 6, blk = (item >> 3) & 7, head = item & 7, tid = otid();
    const bf16_t* z = (const bf16_t*)(a.ws + O_Z);
    bf16_t* tile = (bf16_t*)smem;
    float* part = (float*)(smem + 256 * 136 * 2);
    const int lr = tid >> 4, cgp = tid & 15;
    const size_t t0 = (size_t)b * SEQ + blk * 256;
    float g0[8], g1[8], colsum[8];
    { const float* gp = a.qk_norm + (size_t)l * 256 + cgp * 8;
#pragma unroll
      for (int e = 0; e < 8; ++e) { g0[e] = gp[e] * 0.08838834764831845f; g1[e] = gp[128 + e]; colsum[e] = 0.f; } }
    bf16_t* aqn = (bf16_t*)(a.ws + O_AQN); bf16_t* akn = (bf16_t*)(a.ws + O_AKN);
#pragma unroll 1
    for (int pass = 0; pass < 8; ++pass) {
        const int r = pass * 32 + lr; const bf16_t* zr = z + (t0 + r) * ZLD + head * 128 + cgp * 8;
        float f[8], y[8];
        { unpack8(*(const u32x4*)(zr + 4096), f); float ssq = 0.f;
#pragma unroll
          for (int e = 0; e < 8; ++e) ssq += f[e] * f[e];
          ssq += __shfl_xor(ssq, 1); ssq += __shfl_xor(ssq, 2); ssq += __shfl_xor(ssq, 4); ssq += __shfl_xor(ssq, 8);
          const float rstd = rsqrtf(ssq * (1.0f / 128.0f) + EPS);
#pragma unroll
          for (int e = 0; e < 8; ++e) y[e] = f[e] * rstd * g0[e];
          *(u32x4*)(aqn + (t0 + r) * 1024 + head * 128 + cgp * 8) = pack8(y); }
        { unpack8(*(const u32x4*)(zr + 5120), f); float ssq = 0.f;
#pragma unroll
          for (int e = 0; e < 8; ++e) ssq += f[e] * f[e];
          ssq += __shfl_xor(ssq, 1); ssq += __shfl_xor(ssq, 2); ssq += __shfl_xor(ssq, 4); ssq += __shfl_xor(ssq, 8);
          const float rstd = rsqrtf(ssq * (1.0f / 128.0f) + EPS);
#pragma unroll
          for (int e = 0; e < 8; ++e) { y[e] = f[e] * rstd * g1[e]; colsum[e] += y[e]; }
          *(u32x4*)(akn + (t0 + r) * 1024 + head * 128 + cgp * 8) = pack8(y); }
        *(u32x4*)(tile + r * 136 + cgp * 8) = *(const u32x4*)(zr + 6144);
    }
#pragma unroll
    for (int e = 0; e < 8; ++e) part[lr * 128 + cgp * 8 + e] = colsum[e];
    __syncthreads();
    if (tid < 128) { float s = 0.f;
#pragma unroll 8
        for (int i = 0; i < 32; ++i) s += part[i * 128 + tid];
        ((float*)(a.ws + O_KMEAN))[((size_t)(b * 8 + head) * 8 + blk) * 128 + tid] = s * (1.0f / 256.0f); }
    { const int d = tid >> 2, seg = tid & 3; bf16_t* vT = (bf16_t*)(a.ws + O_AVT) + ((size_t)(b * 8 + head) * 128 + d) * SEQ + blk * 256 + seg * 64;
#pragma unroll
      for (int i = 0; i < 8; ++i) { unsigned wv[4];
#pragma unroll
          for (int j = 0; j < 4; ++j) { const int r = seg * 64 + i * 8 + j * 2; wv[j] = (unsigned)tile[r * 136 + d] | ((unsigned)tile[(r + 1) * 136 + d] << 16); }
          u32x4 v; v.x = wv[0]; v.y = wv[1]; v.z = wv[2]; v.w = wv[3]; *(u32x4*)(vT + i * 8) = v; } }
    __syncthreads();
}

DI void prep_gate_item(const Args& a, int l, int bh) {
    const int tid = otid(); if (tid >= 64) return;
    const int lane = tid, b = bh >> 2, h = bh & 3;
    const float* gates = (const float*)(a.ws + O_GATES); float* gsc = (float*)(a.ws + O_GSC); float* ach = (float*)(a.ws + O_ACH);
    const float bi = a.gate_bias[l * 8 + h], bf = a.gate_bias[l * 8 + 4 + h];
    float m = 0.f;
#pragma unroll 1
    for (int c = 0; c < 32; ++c) {
        const size_t t = (size_t)b * SEQ + c * 64 + lane;
        const float li = gates[t * 8 + h] + bi, xf = gates[t * 8 + 4 + h] + bf;
        const float lf = fminf(xf, 0.f) - log1pf(expf(-fabsf(xf)));
        float bs = lf;
#pragma unroll
        for (int o = 1; o < 64; o <<= 1) { const float v = __shfl_up(bs, o); if (lane >= o) bs += v; }
        const float u = li - bs; float cm = u;
#pragma unroll
        for (int o = 1; o < 64; o <<= 1) { const float v = __shfl_up(cm, o); if (lane >= o) cm = fmaxf(cm, v); }
        const float M = fmaxf(m, cm), W = expf(m - M), F = expf(-(bs + M));
        const float M63 = __shfl(M, 63), bL = __shfl(bs, 63);
        const size_t o = (size_t)bh * SEQ + c * 64 + lane;
        gsc[o] = u; gsc[32768 + o] = M; gsc[65536 + o] = W; gsc[98304 + o] = F; gsc[131072 + o] = expf(u - M63);
        if (lane == 0) ach[bh * 32 + c] = expf(m - M63);
        m = bL + M63;
    }
}

DI void phase_prep(const Args& a, int l, unsigned char* smem) {
    for (int it = blockIdx.x; it < 512 + 256 + 16; it += gridDim.x) {
        if (it < 512) prep_mlstm_item(a, l, it, smem);
        else if (it < 768) prep_attn_item(a, l, it - 512, smem);
        else prep_gate_item(a, l, it - 768);
    }
    u64* hss = (u64*)(a.ws + O_HSS);
    for (int i = blockIdx.x * 512 + otid(); i < T_TOK * 4; i += gridDim.x * 512) hss[i] = 0ull;
}

constexpr int ML_QS = 0, ML_KS = 33792, ML_KTS = 67584, ML_VTS = 104448, ML_VTW = 106752, ML_PS = 109056, ML_CTS = 118272, ML_NV = 135168, ML_SC = 136192, ML_RS = 137472, ML_QN = 137728;

DI void mlstm_item(const Args& a, int item, unsigned char* smem) {
    const int bh = item >> 4, es = item & 15, b = bh >> 2, h = bh & 3, e0 = es * 16;
    const int tid = otid(), w = tid >> 6, lane = tid & 63, fr = lane & 15, fq = lane >> 4;
    bf16_t* Qs = (bf16_t*)(smem + ML_QS); bf16_t* Ks = (bf16_t*)(smem + ML_KS); bf16_t* KTs = (bf16_t*)(smem + ML_KTS); bf16_t* VTs = (bf16_t*)(smem + ML_VTS);
    bf16_t* VTw = (bf16_t*)(smem + ML_VTW); bf16_t* Ps = (bf16_t*)(smem + ML_PS); bf16_t* CTs = (bf16_t*)(smem + ML_CTS);
    float* nvec = (float*)(smem + ML_NV); float* sc = (float*)(smem + ML_SC); float* rowsum = (float*)(smem + ML_RS); float* qn = (float*)(smem + ML_QN);
    const bf16_t* qc = (const bf16_t*)(a.ws + O_QC); const bf16_t* kc = (const bf16_t*)(a.ws + O_KC);
    const bf16_t* kT = (const bf16_t*)(a.ws + O_KT); const bf16_t* vT = (const bf16_t*)(a.ws + O_VT);
    const float* gsc = (const float*)(a.ws + O_GSC); const float* ach = (const float*)(a.ws + O_ACH);
    float* hbuf = (float*)(a.ws + O_HBUF); u64* hss = (u64*)(a.ws + O_HSS);

    u32x4 pq[4], pk[4], pt[4], pv; f32x4 pwk0, pwk1; float psc;
    pv = (u32x4){0u, 0u, 0u, 0u}; pwk0 = (f32x4){0.f, 0.f, 0.f, 0.f}; pwk1 = pwk0; psc = 0.f;
    const int qrow = tid >> 3, qseg = tid & 7, kd = tid >> 1, khalf = tid & 1;
#define ML_LOAD(cc) do { \
        const size_t tb = (size_t)b * SEQ + (cc) * 64; \
        _Pragma("unroll") for (int i = 0; i < 4; ++i) { pq[i] = *(const u32x4*)(qc + (tb + qrow) * 1024 + h * 256 + (qseg + 8 * i) * 8); pk[i] = *(const u32x4*)(kc + (tb + qrow) * 1024 + h * 256 + (qseg + 8 * i) * 8); \
            pt[i] = *(const u32x4*)(kT + ((size_t)(bh * 32 + (cc)) * 256 + kd) * 64 + khalf * 32 + i * 8); } \
        if (tid < 128) { pv = *(const u32x4*)(vT + ((size_t)(bh * 32 + (cc)) * 256 + e0 + (tid >> 3)) * 64 + (tid & 7) * 8); \
            const float* wp = gsc + 131072 + (size_t)bh * SEQ + (cc) * 64 + (tid & 7) * 8; pwk0 = *(const f32x4*)wp; pwk1 = *(const f32x4*)(wp + 4); } \
        else if (tid < 448) { const int ar = (tid - 128) >> 6, s = (tid - 128) & 63; psc = gsc[(size_t)ar * 32768 + (size_t)bh * SEQ + (cc) * 64 + s]; } } while (0)
#define ML_STORE() do { \
        _Pragma("unroll") for (int i = 0; i < 4; ++i) { *(u32x4*)(Qs + qrow * 264 + (qseg + 8 * i) * 8) = pq[i]; *(u32x4*)(Ks + qrow * 264 + (qseg + 8 * i) * 8) = pk[i]; \
            *(u32x4*)(KTs + kd * 72 + khalf * 32 + i * 8) = pt[i]; } \
        if (tid < 128) { *(u32x4*)(VTs + (tid >> 3) * 72 + (tid & 7) * 8) = pv; float f[8]; unpack8(pv, f); \
            f[0] *= pwk0[0]; f[1] *= pwk0[1]; f[2] *= pwk0[2]; f[3] *= pwk0[3]; f[4] *= pwk1[0]; f[5] *= pwk1[1]; f[6] *= pwk1[2]; f[7] *= pwk1[3]; \
            *(u32x4*)(VTw + (tid >> 3) * 72 + (tid & 7) * 8) = pack8(f); } \
        else if (tid < 448) sc[tid - 128] = psc; \
        if (tid < 64) rowsum[tid] = 0.f; } while (0)

    __syncthreads();
    ML_LOAD(0);
    for (int i = tid; i < 2 * 16 * 264 / 2; i += 512) ((unsigned*)CTs)[i] = 0u;
    if (tid < 256) nvec[tid] = 0.f;
    ML_STORE();
    f32x4 accC[2]; accC[0] = (f32x4){0.f, 0.f, 0.f, 0.f}; accC[1] = accC[0];
    __syncthreads();

#pragma unroll 1
    for (int c = 0; c < 32; ++c) {
        const int cur = c & 1;
        if (c + 1 < 32) ML_LOAD(c + 1);
        const float adec = ach[bh * 32 + c];
        { const int rt = w >> 1; float rs2 = 0.f;
#pragma unroll
          for (int ci = 0; ci < 2; ++ci) { const int ct = 2 * (w & 1) + ci;
              const int t = rt * 16 + fr, s0 = ct * 16 + 4 * fq;
              u32x2 pw; pw.x = 0u; pw.y = 0u;
              if (ct <= rt) {
                  f32x4 acc = {0.f, 0.f, 0.f, 0.f};
#pragma unroll
                  for (int kk = 0; kk < 8; ++kk) { const bf16x8 kf = *(const bf16x8*)(Ks + (ct * 16 + fr) * 264 + kk * 32 + fq * 8), qf = *(const bf16x8*)(Qs + (rt * 16 + fr) * 264 + kk * 32 + fq * 8);
                      acc = MFMA16(kf, qf, acc); }
                  const float Mt = sc[64 + t]; float p[4], rs = 0.f;
#pragma unroll
                  for (int j = 0; j < 4; ++j) { const int s = s0 + j; p[j] = (s <= t) ? acc[j] * __expf(sc[s] - Mt) : 0.f; rs += p[j]; }
                  rs += __shfl_xor(rs, 16); rs += __shfl_xor(rs, 32);
                  rs2 += rs;
                  pw.x = pk2(p[0], p[1]); pw.y = pk2(p[2], p[3]);
              }
              *(u32x2*)(Ps + t * 72 + s0) = pw; }
          if (fq == 0) atomicAdd(rowsum + rt * 16 + fr, rs2);
          { const int t = tid >> 3, pr = tid & 7; float dsum = 0.f;
#pragma unroll
            for (int i = 0; i < 4; ++i) { float f[8]; unpack8(*(const u32x4*)(Qs + t * 264 + pr * 32 + i * 8), f);
#pragma unroll
                for (int e = 0; e < 8; ++e) dsum += f[e] * nvec[pr * 32 + i * 8 + e]; }
            dsum += __shfl_xor(dsum, 1); dsum += __shfl_xor(dsum, 2); dsum += __shfl_xor(dsum, 4);
            if (pr == 0) qn[t] = dsum; } }
        __syncthreads();
        if (w < 4) {
            const int rt = w; f32x4 a1 = {0.f, 0.f, 0.f, 0.f}, a2 = {0.f, 0.f, 0.f, 0.f};
            const bf16_t* CTc = CTs + cur * 16 * 264;
#pragma unroll
            for (int kk = 0; kk < 8; ++kk) { const bf16x8 cf = *(const bf16x8*)(CTc + fr * 264 + kk * 32 + fq * 8), qf = *(const bf16x8*)(Qs + (rt * 16 + fr) * 264 + kk * 32 + fq * 8);
                a1 = MFMA16(cf, qf, a1); }
#pragma unroll
            for (int kk = 0; kk < 2; ++kk) { const bf16x8 vf = *(const bf16x8*)(VTs + fr * 72 + kk * 32 + fq * 8), pf = *(const bf16x8*)(Ps + (rt * 16 + fr) * 72 + kk * 32 + fq * 8);
                a2 = MFMA16(vf, pf, a2); }
            const int t = rt * 16 + fr; const float Wt = sc[128 + t], Ft = sc[192 + t];
            const float den = Wt * qn[t] + rowsum[t]; const float inv = 1.0f / fmaxf(fabsf(den), Ft);
            f32x4 hv; float hs = 0.f;
#pragma unroll
            for (int j = 0; j < 4; ++j) { hv[j] = (Wt * a1[j] + a2[j]) * inv; hs += hv[j] * hv[j]; }
            const size_t tg = (size_t)b * SEQ + c * 64 + t;
            *(f32x4*)(hbuf + tg * 1024 + h * 256 + e0 + 4 * fq) = hv;
            hs += __shfl_xor(hs, 16); hs += __shfl_xor(hs, 32);
            if (fq == 0) atomicAdd(hss + tg * 4 + h, to_fix(hs, HS_SCALE));
        }
        { bf16_t* CTn = CTs + (cur ^ 1) * 16 * 264;
#pragma unroll
          for (int i = 0; i < 2; ++i) { const int blk = 2 * w + i; f32x4 acc = accC[i] * adec;
#pragma unroll
              for (int kk = 0; kk < 2; ++kk) { const bf16x8 kf = *(const bf16x8*)(KTs + (blk * 16 + fr) * 72 + kk * 32 + fq * 8), vf = *(const bf16x8*)(VTw + fr * 72 + kk * 32 + fq * 8);
                  acc = MFMA16(kf, vf, acc); }
              accC[i] = acc; u32x2 pw; pw.x = pk2(acc[0], acc[1]); pw.y = pk2(acc[2], acc[3]);
              *(u32x2*)(CTn + fr * 264 + blk * 16 + 4 * fq) = pw; } }
        if (tid < 256) { float s = 0.f;
#pragma unroll
            for (int i = 0; i < 8; ++i) { float f[8]; unpack8(*(const u32x4*)(KTs + tid * 72 + i * 8), f);
#pragma unroll
                for (int e = 0; e < 8; ++e) s += f[e] * sc[256 + i * 8 + e]; }
            nvec[tid] = adec * nvec[tid] + s; }
        __syncthreads();
        if (c + 1 < 32) ML_STORE();
        __syncthreads();
    }
#undef ML_LOAD
#undef ML_STORE
}

constexpr int AT_K = 0, AT_V = 34816, AT_P = 71680, AT_BIAS = 90112, AT_KM = 98304;

DI void attn_item(const Args& a, int b, int head, int qt, unsigned char* smem) {
    const int tid = otid(), w = tid >> 6, lane = tid & 63, fr = lane & 15, fq = lane >> 4;
    const int bh = b * 8 + head, qblk = qt >> 1, q0 = qt * 128 + w * 16;
    bf16_t* Kt = (bf16_t*)(smem + AT_K); bf16_t* Vt = (bf16_t*)(smem + AT_V); bf16_t* Pw = (bf16_t*)(smem + AT_P) + w * 16 * 72;
    float* biasTab = (float*)(smem + AT_BIAS); float* km = (float*)(smem + AT_KM);
    const bf16_t* aqn = (const bf16_t*)(a.ws + O_AQN); const bf16_t* akn = (const bf16_t*)(a.ws + O_AKN); const bf16_t* avT = (const bf16_t*)(a.ws + O_AVT);
    __syncthreads();
    for (int i = tid; i < 2048; i += 512) biasTab[i] = ((const float*)(a.ws + O_BIAST))[head * 2048 + i];
    for (int i = tid; i < 1024; i += 512) km[i] = ((const float*)(a.ws + O_KMEAN))[(size_t)bh * 1024 + i];
    bf16x8 qf[4];
    { const bf16_t* qp = aqn + ((size_t)b * SEQ + q0 + fr) * 1024 + head * 128 + fq * 8;
#pragma unroll
      for (int kk = 0; kk < 4; ++kk) qf[kk] = *(const bf16x8*)(qp + kk * 32); }
    const int krow = tid >> 3, kseg = tid & 7, vd = tid >> 2, vseg = tid & 3;
    u32x4 pkr[2], pvr[2];
#define AT_LOAD(kt) do { _Pragma("unroll") for (int i = 0; i < 2; ++i) { \
        pkr[i] = *(const u32x4*)(akn + ((size_t)b * SEQ + (kt) * 64 + krow) * 1024 + head * 128 + kseg * 8 + i * 64); \
        pvr[i] = *(const u32x4*)(avT + ((size_t)bh * 128 + vd) * SEQ + (kt) * 64 + vseg * 8 + i * 32); } } while (0)
#define AT_STORE(buf) do { _Pragma("unroll") for (int i = 0; i < 2; ++i) { \
        *(u32x4*)(Kt + (buf) * 64 * 136 + krow * 136 + kseg * 8 + i * 64) = pkr[i]; \
        *(u32x4*)(Vt + (buf) * 128 * 72 + vd * 72 + vseg * 8 + i * 32) = pvr[i]; } } while (0)
    AT_LOAD(0);
    __syncthreads();
    unsigned selmask;
    { float g[8];
#pragma unroll
      for (int n = 0; n < 8; ++n) { float p = 0.f;
#pragma unroll
          for (int kk = 0; kk < 4; ++kk)
#pragma unroll
              for (int i = 0; i < 8; ++i) p += bf1((bf16_t)qf[kk][i]) * km[n * 128 + kk * 32 + fq * 8 + i];
          p += __shfl_xor(p, 16); p += __shfl_xor(p, 32); g[n] = p; }
      if (qblk <= 3) selmask = (1u << qblk) - 1u;
      else { selmask = 0u;
#pragma unroll
          for (int r = 0; r < 3; ++r) { float best = -INFINITY; int bi = 0;
#pragma unroll
              for (int n = 0; n < 8; ++n) if (n < qblk && !((selmask >> n) & 1u) && g[n] > best) { best = g[n]; bi = n; }
              selmask |= 1u << bi; } } }
    AT_STORE(0);
    __syncthreads();
    const int nkt = 2 * (qt + 1);
    f32x4 o[8];
#pragma unroll
    for (int i = 0; i < 8; ++i) o[i] = (f32x4){0.f, 0.f, 0.f, 0.f};
    float mrun = -INFINITY, lrun = 0.f;
    const int qpos = q0 + fr;
#pragma unroll 1
    for (int kt = 0; kt < nkt; ++kt) {
        const int cur = kt & 1;
        if (kt + 1 < nkt) AT_LOAD(kt + 1);
        const int n = kt >> 2; const bool own = (n == qblk);
        const bool lane_sel = ((selmask >> n) & 1u) != 0u;
        const bool active = own ? (kt * 64 <= q0 + 15) : (__ballot(lane_sel) != 0ull);
        if (active) {
            const bf16_t* Kc = Kt + cur * 64 * 136; const bf16_t* Vc = Vt + cur * 128 * 72;
            f32x4 s[4];
#pragma unroll
            for (int ct = 0; ct < 4; ++ct) { s[ct] = (f32x4){0.f, 0.f, 0.f, 0.f};
#pragma unroll
                for (int kk = 0; kk < 4; ++kk) { const bf16x8 kf = *(const bf16x8*)(Kc + (ct * 16 + fr) * 136 + kk * 32 + fq * 8); s[ct] = MFMA16(kf, qf[kk], s[ct]); } }
            float mx = -INFINITY;
#pragma unroll
            for (int ct = 0; ct < 4; ++ct)
#pragma unroll
                for (int j = 0; j < 4; ++j) { const int kpos = kt * 64 + ct * 16 + 4 * fq + j; const int rel = qpos - kpos;
                    const bool valid = own ? (rel >= 0) : lane_sel;
                    const float v = valid ? s[ct][j] + biasTab[rel > 0 ? rel : 0] : -INFINITY; s[ct][j] = v; mx = fmaxf(mx, v); }
            mx = fmaxf(mx, __shfl_xor(mx, 16)); mx = fmaxf(mx, __shfl_xor(mx, 32));
            const float mnew = fmaxf(mrun, mx), msafe = (mnew == -INFINITY) ? 0.f : mnew;
            const float alpha = __expf(mrun - msafe); mrun = mnew;
            float ps = 0.f;
#pragma unroll
            for (int ct = 0; ct < 4; ++ct) { float p[4];
#pragma unroll
                for (int j = 0; j < 4; ++j) { p[j] = __expf(s[ct][j] - msafe); ps += p[j]; }
                u32x2 pw; pw.x = pk2(p[0], p[1]); pw.y = pk2(p[2], p[3]); *(u32x2*)(Pw + fr * 72 + ct * 16 + 4 * fq) = pw; }
            lrun = lrun * alpha + ps;
#pragma unroll
            for (int dt = 0; dt < 8; ++dt) o[dt] = o[dt] * alpha;
            const bf16x8 pf0 = *(const bf16x8*)(Pw + fr * 72 + fq * 8), pf1 = *(const bf16x8*)(Pw + fr * 72 + 32 + fq * 8);
#pragma unroll
            for (int dt = 0; dt < 8; ++dt) { const bf16x8 v0 = *(const bf16x8*)(Vc + (dt * 16 + fr) * 72 + fq * 8), v1 = *(const bf16x8*)(Vc + (dt * 16 + fr) * 72 + 32 + fq * 8);
                o[dt] = MFMA16(v0, pf0, o[dt]); o[dt] = MFMA16(v1, pf1, o[dt]); }
        }
        if (kt + 1 < nkt) AT_STORE(cur ^ 1);
        __syncthreads();
    }
    lrun += __shfl_xor(lrun, 16); lrun += __shfl_xor(lrun, 32);
    const float inv = 1.0f / lrun;
    bf16_t* op = (bf16_t*)(a.ws + O_MIX) + ((size_t)b * SEQ + qpos) * DM + 1024 + head * 128 + 4 * fq;
#pragma unroll
    for (int dt = 0; dt < 8; ++dt) { u32x2 pw; pw.x = pk2(o[dt][0] * inv, o[dt][1] * inv); pw.y = pk2(o[dt][2] * inv, o[dt][3] * inv); *(u32x2*)(op + dt * 16) = pw; }
#undef AT_LOAD
#undef AT_STORE
}

DI void phase_mixer(const Args& a, unsigned char* smem) {
    for (int it = blockIdx.x; it < 256; it += gridDim.x) mlstm_item(a, it, smem);
    for (int it = blockIdx.x; it < 256; it += gridDim.x) { const int bh = it >> 3, j = it & 7; attn_item(a, bh >> 3, bh & 7, j, smem); attn_item(a, bh >> 3, bh & 7, 15 - j, smem); }
}

DI void phase_hnorm(const Args& a, int l) {
    const float* hbuf = (const float*)(a.ws + O_HBUF); const u64* hss = (const u64*)(a.ws + O_HSS); const bf16_t* z = (const bf16_t*)(a.ws + O_Z);
    bf16_t* mix = (bf16_t*)(a.ws + O_MIX); const float* gn = a.mlstm_norm + (size_t)l * 1024;
    for (int i = blockIdx.x * 512 + otid(); i < T_TOK * 128; i += gridDim.x * 512) {
        const int t = i >> 7, c = (i & 127) * 8;
        const float rstd = rsqrtf((float)hss[(size_t)t * 4 + (c >> 8)] * (HS_INV / 256.0f) + EPS);
        const f32x4 h0 = *(const f32x4*)(hbuf + (size_t)t * 1024 + c), h1 = *(const f32x4*)(hbuf + (size_t)t * 1024 + c + 4);
        const f32x4 g0 = *(const f32x4*)(gn + c), g1 = *(const f32x4*)(gn + c + 4);
        float mo[8], y[8]; unpack8(*(const u32x4*)(z + (size_t)t * ZLD + 3072 + c), mo);
#pragma unroll
        for (int e = 0; e < 4; ++e) { y[e] = h0[e] * rstd * g0[e] * sigmoidf_(mo[e]); y[4 + e] = h1[e] * rstd * g1[e] * sigmoidf_(mo[4 + e]); }
        *(u32x4*)(mix + (size_t)t * DM + c) = pack8(y);
    }
}

DI void phase_ffnconv(const Args& a, int l) {
    const bf16_t* u = (const bf16_t*)(a.ws + O_U); bf16_t* act = (bf16_t*)(a.ws + O_ACT);
    const float* cw = a.conv_ffn_w + (size_t)l * 3 * DFF2; const float* cb = a.conv_ffn_b + (size_t)l * DFF2;
    constexpr int NCG = DFF / 8;
    for (int i = blockIdx.x * 512 + otid(); i < (T_TOK / 16) * NCG; i += gridDim.x * 512) {
        const int rb = i / NCG, f = (i % NCG) * 8; const int t0 = rb * 16; const bool first = (t0 % SEQ) == 0;
        float wg[3][8], wv[3][8], bg[8], bv[8];
#pragma unroll
        for (int j = 0; j < 3; ++j) { const f32x4 p0 = *(const f32x4*)(cw + j * DFF2 + f), p1 = *(const f32x4*)(cw + j * DFF2 + f + 4), q0 = *(const f32x4*)(cw + j * DFF2 + DFF + f), q1 = *(const f32x4*)(cw + j * DFF2 + DFF + f + 4);
#pragma unroll
            for (int e = 0; e < 4; ++e) { wg[j][e] = p0[e]; wg[j][4 + e] = p1[e]; wv[j][e] = q0[e]; wv[j][4 + e] = q1[e]; } }
        { const f32x4 p0 = *(const f32x4*)(cb + f), p1 = *(const f32x4*)(cb + f + 4), q0 = *(const f32x4*)(cb + DFF + f), q1 = *(const f32x4*)(cb + DFF + f + 4);
#pragma unroll
          for (int e = 0; e < 4; ++e) { bg[e] = p0[e]; bg[4 + e] = p1[e]; bv[e] = q0[e]; bv[4 + e] = q1[e]; } }
        float g0[8], g1[8], v0[8], v1[8];
        if (first) {
#pragma unroll
            for (int e = 0; e < 8; ++e) { g0[e] = 0.f; g1[e] = 0.f; v0[e] = 0.f; v1[e] = 0.f; }
        } else {
            unpack8(*(const u32x4*)(u + (size_t)(t0 - 2) * DFF2 + f), g0); unpack8(*(const u32x4*)(u + (size_t)(t0 - 1) * DFF2 + f), g1);
            unpack8(*(const u32x4*)(u + (size_t)(t0 - 2) * DFF2 + DFF + f), v0); unpack8(*(const u32x4*)(u + (size_t)(t0 - 1) * DFF2 + DFF + f), v1);
        }
#pragma unroll 4
        for (int r = 0; r < 16; ++r) { float g2[8], v2[8], y[8];
            unpack8(*(const u32x4*)(u + (size_t)(t0 + r) * DFF2 + f), g2); unpack8(*(const u32x4*)(u + (size_t)(t0 + r) * DFF2 + DFF + f), v2);
#pragma unroll
            for (int e = 0; e < 8; ++e) { const float G = bg[e] + wg[0][e] * g0[e] + wg[1][e] * g1[e] + wg[2][e] * g2[e]; const float V = bv[e] + wv[0][e] * v0[e] + wv[1][e] * v1[e] + wv[2][e] * v2[e];
                y[e] = siluf_(G) * V; g0[e] = g1[e]; g1[e] = g2[e]; v0[e] = v1[e]; v1[e] = v2[e]; }
            *(u32x4*)(act + (size_t)(t0 + r) * DFF + f) = pack8(y); }
    }
}

__global__ void __launch_bounds__(512) mega_fwd(Args a) {
    extern __shared__ __attribute__((aligned(16))) unsigned char smem[];
    cg::grid_group grid = cg::this_grid();
    constexpr int NPH = 1 + 8 * DEPTH;
#pragma unroll 1
    for (int ph = 0; ph < NPH; ++ph) {
        const int l = (ph - 1) >> 3, k = (ph - 1) & 7;
        u64* ss = (u64*)(a.ws + O_SS);
        bf16_t* xb = (bf16_t*)(a.ws + O_XB);
        if (ph == 0) phase0(a, smem);
        else if (k == 0 || k == 5) {
            EpiScale E; const bf16_t* Bt; int N;
            if (k == 0) { E.O = (bf16_t*)(a.ws + O_Z); E.ldc = ZLD; E.SS = ss + (size_t)(2 * l) * T_TOK; E.gates = (float*)(a.ws + O_GATES); E.gate_pn = 28; Bt = (const bf16_t*)(a.ws + O_WIN + l * SZ_WIN); N = DINP; }
            else { E.O = (bf16_t*)(a.ws + O_U); E.ldc = DFF2; E.SS = ss + (size_t)(2 * l + 1) * T_TOK; E.gates = nullptr; E.gate_pn = -1; Bt = (const bf16_t*)(a.ws + O_WUP + l * SZ_WUP); N = DFF2; }
            run_gemm(smem, xb, Bt, T_TOK, N, DM, E);
        } else if (k == 4 || k == 7) {
            EpiRes E; E.X = a.out; E.XB = xb; const bf16_t* A; const bf16_t* Bt; int K;
            if (k == 4) { E.SS = ss + (size_t)(2 * l + 1) * T_TOK; A = (const bf16_t*)(a.ws + O_MIX); Bt = (const bf16_t*)(a.ws + O_WOUT + l * SZ_WOUT); K = DM; }
            else { E.SS = ss + (size_t)(2 * l + 2) * T_TOK; A = (const bf16_t*)(a.ws + O_ACT); Bt = (const bf16_t*)(a.ws + O_WD + l * SZ_WD); K = DFF; }
            run_gemm(smem, A, Bt, T_TOK, DM, K, E);
        } else if (k == 1) phase_prep(a, l, smem);
        else if (k == 2) phase_mixer(a, smem);
        else if (k == 3) phase_hnorm(a, l);
        else phase_ffnconv(a, l);
        if (ph + 1 < NPH) grid.sync();
    }
}

extern "C" void kernel_launch(void* const* d_in, const int* in_sizes, int n_in, void* d_out, int out_size, void* d_ws, size_t ws_size, hipStream_t stream) {
    static int grid = 0;
    if (grid == 0) {
        if (n_in != 15 || out_size != T_TOK * DM || ws_size < WS_END) { fprintf(stderr, "kernel_launch: unexpected shapes (n_in %d out %d ws %zu need %zu)\n", n_in, out_size, ws_size, (size_t)WS_END); grid = -1; return; }
        int dev = 0, cus = 0, per_cu = 0;
        (void)hipGetDevice(&dev); (void)hipDeviceGetAttribute(&cus, hipDeviceAttributeMultiprocessorCount, dev);
        if (hipFuncSetAttribute((const void*)mega_fwd, hipFuncAttributeMaxDynamicSharedMemorySize, LDS_BYTES) != hipSuccess) { fprintf(stderr, "kernel_launch: hipFuncSetAttribute failed\n"); }
        if (hipOccupancyMaxActiveBlocksPerMultiprocessor(&per_cu, (const void*)mega_fwd, 512, LDS_BYTES) != hipSuccess || per_cu < 1) per_cu = 1;
        (void)hipGetLastError();
        grid = cus * (per_cu > 1 ? 1 : per_cu);
        if (grid <= 0) grid = 256;
    }
    if (grid < 0) return;
    Args a{};
    a.x = (const float*)d_in[0]; a.norm_mix = (const float*)d_in[1]; a.w_in = (const float*)d_in[2]; a.gate_bias = (const float*)d_in[3];
    a.conv_qk_w = (const float*)d_in[4]; a.conv_qk_b = (const float*)d_in[5]; a.mlstm_norm = (const float*)d_in[6]; a.qk_norm = (const float*)d_in[7];
    a.rel_bias = (const float*)d_in[8]; a.w_out = (const float*)d_in[9]; a.norm_ffn = (const float*)d_in[10]; a.w_up = (const float*)d_in[11];
    a.conv_ffn_w = (const float*)d_in[12]; a.conv_ffn_b = (const float*)d_in[13]; a.w_down = (const float*)d_in[14];
    a.out = (float*)d_out; a.ws = (unsigned char*)d_ws;
    void* args[] = {&a};
    hipError_t e = hipLaunchCooperativeKernel((const void*)mega_fwd, dim3(grid), dim3(512), args, LDS_BYTES, stream);
    if (e != hipSuccess) fprintf(stderr, "kernel_launch: cooperative launch failed: %s (grid %d)\n", hipGetErrorString(e), grid);
}
```

```cpp
#include <hip/hip_runtime.h>
#include <hip/hip_cooperative_groups.h>
#include <cstdio>
#include <cmath>
namespace cg = cooperative_groups;
__device__ __forceinline__ int olane() { int l; asm volatile("v_mbcnt_lo_u32_b32 %0, -1, 0\n\tv_mbcnt_hi_u32_b32 %0, -1, %0" : "=v"(l)); return l; }
#define otid() ((a.wv << 6) | olane())
__device__ __forceinline__ float shx(float v, int m) { return __builtin_bit_cast(float, __builtin_amdgcn_ds_bpermute((olane() ^ m) << 2, __builtin_bit_cast(int, v))); }
__device__ __forceinline__ float shu(float v, int o) { const int l = olane(); return __builtin_bit_cast(float, __builtin_amdgcn_ds_bpermute((l >= o ? l - o : l) << 2, __builtin_bit_cast(int, v))); }
namespace pg8 {
#define PG8_LAS __attribute__((address_space(3)))
typedef unsigned short bf16_t;
typedef short bf16x8 __attribute__((ext_vector_type(8)));
typedef float f32x4 __attribute__((ext_vector_type(4)));
typedef unsigned u32x4 __attribute__((ext_vector_type(4)));
constexpr int BM = 256, BK = 64, HALF = 128, HTB = HALF * BK * 2  , STAGE_BYTES = 8 * HTB, NXCD = 8, WGM = 8;

__host__ __device__ __forceinline__ int lds_byte(int r, int c) { const int st = (r >> 4) * 2 + (c >> 5), rr = r & 15, cc = c & 31, ob = rr * 64 + cc * 2; return st * 1024 + (ob ^ (((ob >> 9) & 1) << 5)); }
__host__ __device__ __forceinline__ void stage_rc(int b, int& R, int& C) { const int st = b / 1024, sb = b % 1024, swz = sb ^ (((sb >> 9) & 1) << 5); R = (st >> 1) * 16 + swz / 64; C = (st & 1) * 32 + (swz % 64) / 2; }
__host__ __device__ __forceinline__ int perm32(int rho) { const int n = rho >> 4, i = rho & 15; return 8 * (i >> 2) + 4 * n + (i & 3); }

struct Unit { int pm, pn; };
struct Gemm { const bf16_t* A; const bf16_t* Bt; int M, N, K, wv; };

struct StaticOrder {
    int nM, nN, nwg, G, c;
    __host__ __device__ void init(int M, int N, int G_, int c_) { nM = M / BM; nN = N / BM; nwg = nM * nN; G = G_; c = c_; }
    __host__ __device__ bool next(int i, Unit& u) const {
        const long L = (long)i * G + c; if (L >= nwg) return false;
        int wgid = (int)L; { const int q = nwg / NXCD, r = nwg % NXCD, xcd = wgid % NXCD, off = wgid / NXCD; wgid = (xcd < r ? xcd * (q + 1) : r * (q + 1) + (xcd - r) * q) + off; }
        const int nig = WGM * nN, gid = wgid / nig, fm = gid * WGM, gsz = (nM - fm) < WGM ? (nM - fm) : WGM;
        u.pm = fm + ((wgid % nig) % gsz); u.pn = (wgid % nig) / gsz; return true;
    }
    __device__ __forceinline__ void a_ready(const Unit&) const {}
    __device__ __forceinline__ void done(const Unit&) const {}
};

__device__ __forceinline__ unsigned cvt_pk_bf16(float lo, float hi) { unsigned r; asm volatile("v_cvt_pk_bf16_f32 %0, %1, %2" : "=v"(r) : "v"(lo), "v"(hi)); return r; }

template <class Epi, class Sched, bool STAMP = false>
__device__ __forceinline__ void gemm_phase(PG8_LAS unsigned char* lds, const Gemm g, const Sched& S, const Epi& E, unsigned long long* stamps) {
    const int lane = olane(), wid = g.wv, tid = (wid << 6) | lane, wr = wid >> 2, wc = wid & 3, fr = lane & 15, fq = lane >> 4;
    const int K = g.K, nt = K / BK;
    int ts_lo = 0, ts_hi = 0, nts = 0; const unsigned long long rt_entry = STAMP ? (unsigned long long)wall_clock64() : 0ull;
#define PG8_STAMP() do { if (STAMP && wid == 0 && nts < 64) { const unsigned long long _c = (unsigned long long)clock64(); \
        ts_lo = (lane == nts) ? (int)(unsigned)_c : ts_lo; ts_hi = (lane == nts) ? (int)(unsigned)(_c >> 32) : ts_hi; ++nts; } } while (0)
    PG8_STAMP();
    unsigned voffA[2], voffB[2];
#pragma unroll
    for (int i = 0; i < 2; ++i) { int R, C; stage_rc(tid * 16 + i * 8192, R, C); const int Rb = Epi::PERM ? ((R & ~31) + perm32(R & 31)) : R;
        voffA[i] = (unsigned)(R * K + C) * 2u; voffB[i] = (unsigned)(Rb * K + C) * 2u; }
    const size_t kstep = (size_t)(BK * 2);
    const size_t hstep = (size_t)HALF * K * 2;
    const size_t tstep = 2 * hstep;
    const unsigned ldsw = (unsigned)wid * 1024u;
    const int aoff = lds_byte(wr * 64 + fr, fq * 8), boff = lds_byte(wc * 32 + fr, fq * 8);
#define PG8_SA(b, h) (((b) * 2 + (h)) * HTB)
#define PG8_SB(b, h) ((4 + (b) * 2 + (h)) * HTB)
#define PG8_STAGE(bufoff, gbase, voff) do { _Pragma("unroll") for (int _i = 0; _i < 2; ++_i) \
        __builtin_amdgcn_global_load_lds((const unsigned*)((const char*)(gbase) + (voff)[_i]), (PG8_LAS unsigned*)(lds + (bufoff) + ldsw + _i * 8192), 16, 0, 0); } while (0)
#define PG8_LDA(dst, b, h) do { _Pragma("unroll") for (int m = 0; m < 4; ++m) _Pragma("unroll") for (int k = 0; k < 2; ++k) dst[m][k] = *(const PG8_LAS bf16x8*)(lds + PG8_SA(b, h) + aoff + m * 2048 + k * 1024); } while (0)
#define PG8_LDB(dst, b, h) do { _Pragma("unroll") for (int n = 0; n < 2; ++n) _Pragma("unroll") for (int k = 0; k < 2; ++k) dst[n][k] = *(const PG8_LAS bf16x8*)(lds + PG8_SB(b, h) + boff + n * 2048 + k * 1024); } while (0)
#define PG8_MMA(ai, bj, At, Bt) do { __builtin_amdgcn_s_setprio(1); _Pragma("unroll") for (int m = 0; m < 4; ++m) _Pragma("unroll") for (int n = 0; n < 2; ++n) _Pragma("unroll") for (int k = 0; k < 2; ++k) \
        acc[ai][bj][m][n] = __builtin_amdgcn_mfma_f32_16x16x32_bf16(Bt[n][k], At[m][k], acc[ai][bj][m][n], 0, 0, 0); __builtin_amdgcn_s_setprio(0); } while (0)
#define PG8_WAIT_V(n) asm volatile("s_waitcnt vmcnt(" #n ")" ::: "memory")
#define PG8_WAIT_L(n) asm volatile("s_waitcnt lgkmcnt(" #n ")" ::: "memory")
#define PG8_BAR __builtin_amdgcn_s_barrier()
#define PG8_SCHED __builtin_amdgcn_sched_barrier(0)
    Unit cur, nxt; int ui = 0;
    if (!S.next(0, cur)) return;
    f32x4 acc[2][2][4][2];
#pragma unroll
    for (int a = 0; a < 2; ++a)
#pragma unroll
        for (int b = 0; b < 2; ++b)
#pragma unroll
            for (int m = 0; m < 4; ++m)
#pragma unroll
                for (int n = 0; n < 2; ++n) acc[a][b][m][n] = (f32x4){0.f, 0.f, 0.f, 0.f};
    bf16x8 At[4][2], B0[2][2], B1[2][2];
    const char* cA = (const char*)g.A + (size_t)cur.pm * tstep; const char* cB = (const char*)g.Bt + (size_t)cur.pn * tstep;
    S.a_ready(cur);
    PG8_STAGE(PG8_SB(0, 0), cB, voffB); PG8_STAGE(PG8_SA(0, 0), cA, voffA); PG8_STAGE(PG8_SB(0, 1), cB + hstep, voffB); PG8_STAGE(PG8_SA(0, 1), cA + hstep, voffA);
    if (wr == 1) PG8_BAR;
    PG8_WAIT_V(4); PG8_BAR;
    PG8_STAGE(PG8_SB(1, 0), cB + kstep, voffB); PG8_STAGE(PG8_SA(1, 0), cA + kstep, voffA); PG8_STAGE(PG8_SB(1, 1), cB + hstep + kstep, voffB);
    PG8_WAIT_V(6); PG8_BAR;
    PG8_STAMP();
    for (;;) {
        const bool has_next = S.next(ui + 1, nxt);
        const char* nA = has_next ? (const char*)g.A + (size_t)nxt.pm * tstep : cA; const char* nB = has_next ? (const char*)g.Bt + (size_t)nxt.pn * tstep : cB;
        for (int t = 0; t < nt; t += 2) {
            const bool last = (t == nt - 2);
            const char* a1 = cA + (size_t)(t + 1) * kstep;
            const char* a2 = last ? nA : cA + (size_t)(t + 2) * kstep; const char* b2 = last ? nB : cB + (size_t)(t + 2) * kstep;
            const char* a3 = a2 + kstep; const char* b3 = b2 + kstep;
            if (last && has_next) S.a_ready(nxt);
            PG8_LDB(B0, 0, 0); PG8_SCHED; PG8_LDA(At, 0, 0); PG8_STAGE(PG8_SA(1, 1), a1 + hstep, voffA);
            PG8_WAIT_L(8); PG8_BAR; PG8_WAIT_L(0); PG8_MMA(0, 0, At, B0); PG8_BAR; PG8_SCHED;
            PG8_LDB(B1, 0, 1); PG8_STAGE(PG8_SB(0, 0), b2, voffB);
            PG8_BAR; PG8_WAIT_L(0); PG8_MMA(0, 1, At, B1); PG8_BAR;
            PG8_LDA(At, 0, 1); PG8_STAGE(PG8_SA(0, 0), a2, voffA);
            PG8_BAR; PG8_WAIT_L(0); PG8_MMA(1, 0, At, B0); PG8_BAR; PG8_SCHED;
            PG8_STAGE(PG8_SB(0, 1), b2 + hstep, voffB);
            PG8_WAIT_V(6); PG8_BAR; PG8_MMA(1, 1, At, B1); PG8_BAR;
            PG8_LDB(B0, 1, 0); PG8_SCHED; PG8_LDA(At, 1, 0); PG8_STAGE(PG8_SA(0, 1), a2 + hstep, voffA);
            PG8_WAIT_L(8); PG8_BAR; PG8_WAIT_L(0); PG8_MMA(0, 0, At, B0); PG8_BAR; PG8_SCHED;
            PG8_LDB(B1, 1, 1); PG8_STAGE(PG8_SB(1, 0), b3, voffB);
            PG8_BAR; PG8_WAIT_L(0); PG8_MMA(0, 1, At, B1); PG8_BAR;
            PG8_LDA(At, 1, 1); PG8_STAGE(PG8_SA(1, 0), a3, voffA);
            PG8_BAR; PG8_WAIT_L(0); PG8_MMA(1, 0, At, B0); PG8_BAR; PG8_SCHED;
            PG8_STAGE(PG8_SB(1, 1), b3 + hstep, voffB);
            PG8_WAIT_V(6); PG8_BAR; PG8_MMA(1, 1, At, B1); PG8_BAR;
        }
        PG8_STAMP();
        if constexpr (!Epi::AFTER_DRAIN) { E(acc, cur, wr, wc, fr, fq); S.done(cur); }
        PG8_STAMP();
        if (!has_next) break;
#pragma unroll
        for (int a = 0; a < 2; ++a)
#pragma unroll
            for (int b = 0; b < 2; ++b)
#pragma unroll
                for (int m = 0; m < 4; ++m)
#pragma unroll
                    for (int n = 0; n < 2; ++n) acc[a][b][m][n] = (f32x4){0.f, 0.f, 0.f, 0.f};
        cur = nxt; cA = nA; cB = nB; ++ui;
    }
    PG8_WAIT_V(0);
    if (wr == 0) PG8_BAR;
    PG8_BAR;
    if constexpr (Epi::AFTER_DRAIN) { E.fused(acc, cur, wr, wc, fr, fq, lds, wid, lane); S.done(cur); }
    PG8_STAMP();
    if (STAMP && wid == 0) { stamps[lane] = lane < nts ? (((unsigned long long)(unsigned)ts_hi << 32) | (unsigned)ts_lo) : 0ull;
        if (lane == 62) stamps[62] = rt_entry; if (lane == 63) stamps[63] = (unsigned long long)wall_clock64(); }
#undef PG8_STAMP
#undef PG8_SA
#undef PG8_SB
#undef PG8_STAGE
#undef PG8_LDA
#undef PG8_LDB
#undef PG8_MMA
#undef PG8_WAIT_V
#undef PG8_WAIT_L
#undef PG8_BAR
#undef PG8_SCHED
}
}

using pg8::bf16_t; using pg8::bf16x8; using pg8::f32x4; using pg8::u32x4;
typedef unsigned u32x2 __attribute__((ext_vector_type(2)));
#define LAS __attribute__((address_space(3)))
#define DI __device__ __forceinline__
#define MFMA16(a, b, c) __builtin_amdgcn_mfma_f32_16x16x32_bf16((a), (b), (c), 0, 0, 0)

constexpr int T_TOK = 8192, DM = 2048, SEQ = 2048, DEPTH = 4;
constexpr int DIN_SRC = 7176, DINP = 7424, ZLD = 7168, DFF = 5632, DFF2 = 11264;
constexpr int LDS_BYTES = 147456;
constexpr float EPS = 1e-6f;

constexpr size_t al256(size_t x) { return (x + 255) & ~(size_t)255; }
constexpr size_t SZ_WIN = (size_t)DINP * DM * 2, SZ_WOUT = (size_t)DM * DM * 2, SZ_WUP = (size_t)DFF2 * DM * 2, SZ_WD = (size_t)DM * DFF * 2;
constexpr size_t O_WIN = 0;
constexpr size_t O_WOUT = O_WIN + 4 * SZ_WIN;
constexpr size_t O_WUP = O_WOUT + 4 * SZ_WOUT;
constexpr size_t O_WD = O_WUP + 4 * SZ_WUP;
constexpr size_t O_XB = O_WD + 4 * SZ_WD;
constexpr size_t O_Z = O_XB + (size_t)T_TOK * DM * 2;
constexpr size_t O_GATES = O_Z + (size_t)T_TOK * ZLD * 2;
constexpr size_t O_QC = O_GATES + (size_t)T_TOK * 8 * 4;
constexpr size_t O_KC = O_QC + (size_t)T_TOK * 1024 * 2;
constexpr size_t O_KT = O_KC + (size_t)T_TOK * 1024 * 2;
constexpr size_t O_VT = O_KT + (size_t)T_TOK * 1024 * 2;
constexpr size_t O_GSC = O_VT + (size_t)T_TOK * 1024 * 2;
constexpr size_t O_ACH = O_GSC + (size_t)5 * 16 * 2048 * 4;
constexpr size_t O_AQN = O_ACH + 4096;
constexpr size_t O_AKN = O_AQN + (size_t)T_TOK * 1024 * 2;
constexpr size_t O_AVT = O_AKN + (size_t)T_TOK * 1024 * 2;
constexpr size_t O_KMEAN = O_AVT + (size_t)T_TOK * 1024 * 2;
constexpr size_t O_HBUF = O_KMEAN + (size_t)32 * 8 * 128 * 4;
constexpr size_t O_HSS = O_HBUF + (size_t)T_TOK * 1024 * 4;
constexpr size_t O_MIX = O_HSS + (size_t)T_TOK * 4 * 8;
constexpr size_t O_U = O_MIX + (size_t)T_TOK * DM * 2;
constexpr size_t O_ACT = O_U + (size_t)T_TOK * DFF2 * 2;
constexpr size_t O_SS = O_ACT + (size_t)T_TOK * DFF * 2;
constexpr size_t O_BIAST = O_SS + (size_t)9 * T_TOK * 8;
constexpr size_t O_TS = O_BIAST + (size_t)8 * 2048 * 4;
constexpr size_t O_CS = O_TS + 4096;
constexpr size_t O_NS = O_CS + (size_t)256 * 32 * 4096 * 2;
constexpr size_t O_BAR = O_NS + (size_t)16 * 32 * 256 * 4;
constexpr size_t WS_END = O_BAR + 16384;

struct Args {
    const float* x; const float* norm_mix; const float* w_in; const float* gate_bias; const float* conv_qk_w; const float* conv_qk_b;
    const float* mlstm_norm; const float* qk_norm; const float* rel_bias; const float* w_out; const float* norm_ffn; const float* w_up;
    const float* conv_ffn_w; const float* conv_ffn_b; const float* w_down;
    float* out; unsigned char* ws;
    int wv; int pad_;
};

DI unsigned f2bf(float f) { unsigned u = __builtin_bit_cast(unsigned, f); return (u + 0x7fffu + ((u >> 16) & 1u)) >> 16; }
typedef __bf16 bf16v2_t __attribute__((ext_vector_type(2)));
typedef float f32x2_t __attribute__((ext_vector_type(2)));
DI unsigned pk2(float lo, float hi) { f32x2_t v = {lo, hi}; return __builtin_bit_cast(unsigned, __builtin_convertvector(v, bf16v2_t)); }
DI float bflo(unsigned w) { return __builtin_bit_cast(float, w << 16); }
DI float bfhi(unsigned w) { return __builtin_bit_cast(float, w & 0xffff0000u); }
DI float bf1(bf16_t b) { return __builtin_bit_cast(float, ((unsigned)b) << 16); }
DI void unpack8(const u32x4 v, float (&f)[8]) { f[0] = bflo(v.x); f[1] = bfhi(v.x); f[2] = bflo(v.y); f[3] = bfhi(v.y); f[4] = bflo(v.z); f[5] = bfhi(v.z); f[6] = bflo(v.w); f[7] = bfhi(v.w); }
DI u32x4 pack8(const float (&f)[8]) { u32x4 r; r.x = pk2(f[0], f[1]); r.y = pk2(f[2], f[3]); r.z = pk2(f[4], f[5]); r.w = pk2(f[6], f[7]); return r; }
typedef unsigned long long u64;
constexpr float SS_SCALE = 268435456.0f, SS_INV = 1.0f / 268435456.0f;
constexpr float HS_SCALE = 4294967296.0f, HS_INV = 1.0f / 4294967296.0f;
DI u64 to_fix(float v, float scale) { return (u64)(v * scale + 0.5f); }
DI void bar_lds() { asm volatile("s_waitcnt lgkmcnt(0)" ::: "memory"); __builtin_amdgcn_s_barrier(); asm volatile("" ::: "memory"); }
DI float sigmoidf_(float x) { return __builtin_amdgcn_rcpf(1.0f + __builtin_amdgcn_exp2f(x * -1.4426950408889634f)); }
DI float siluf_(float x) { return x * __builtin_amdgcn_rcpf(1.0f + __builtin_amdgcn_exp2f(x * -1.4426950408889634f)); }

struct EpiScale {
    static constexpr bool PERM = true, AFTER_DRAIN = false;
    bf16_t* O; int ldc; const u64* SS; float* gates; int gate_pn;
    DI void operator()(const f32x4 (&acc)[2][2][4][2], const pg8::Unit& u, int wr, int wc, int fr, int fq) const {
        const int row0 = u.pm * 256 + wr * 64 + fr, col0 = u.pn * 256 + wc * 32 + 8 * fq;
#pragma unroll
        for (int ai = 0; ai < 2; ++ai)
#pragma unroll
            for (int m = 0; m < 4; ++m) {
                const int r = row0 + ai * 128 + m * 16;
                const float rstd = rsqrtf((float)SS[r] * (SS_INV / 2048.0f) + EPS);
                if (u.pn == gate_pn) {
                    if (wc == 0 && fq == 0) { *(f32x4*)(gates + (size_t)r * 8) = acc[ai][0][m][0] * rstd; *(f32x4*)(gates + (size_t)r * 8 + 4) = acc[ai][0][m][1] * rstd; }
                } else {
                    bf16_t* rowp = O + (size_t)r * ldc + col0;
#pragma unroll
                    for (int bj = 0; bj < 2; ++bj) { const f32x4 v0 = acc[ai][bj][m][0] * rstd, v1 = acc[ai][bj][m][1] * rstd;
                        u32x4 w; w.x = pk2(v0[0], v0[1]); w.y = pk2(v0[2], v0[3]); w.z = pk2(v1[0], v1[1]); w.w = pk2(v1[2], v1[3]);
                        *(u32x4*)(rowp + bj * 128) = w; }
                }
            }
    }
};
struct EpiRes {
    static constexpr bool PERM = false, AFTER_DRAIN = false;
    float* X; bf16_t* XB; u64* SS;
    DI void operator()(const f32x4 (&acc)[2][2][4][2], const pg8::Unit& u, int wr, int wc, int fr, int fq) const {
        const int row0 = u.pm * 256 + wr * 64 + fr, col0 = u.pn * 256 + wc * 32 + 4 * fq;
#pragma unroll
        for (int ai = 0; ai < 2; ++ai)
#pragma unroll
            for (int m = 0; m < 4; ++m) {
                const int r = row0 + ai * 128 + m * 16;
                bf16_t* bp = XB + (size_t)r * DM + col0; float ssq = 0.f;
                u32x2 old[2][2];
#pragma unroll
                for (int bj = 0; bj < 2; ++bj)
#pragma unroll
                    for (int n = 0; n < 2; ++n) old[bj][n] = *(const u32x2*)(bp + bj * 128 + n * 16);
#pragma unroll
                for (int bj = 0; bj < 2; ++bj)
#pragma unroll
                    for (int n = 0; n < 2; ++n) { f32x4 v = acc[ai][bj][m][n];
                        v[0] += bflo(old[bj][n].x); v[1] += bfhi(old[bj][n].x); v[2] += bflo(old[bj][n].y); v[3] += bfhi(old[bj][n].y);
                        ssq += v[0] * v[0] + v[1] * v[1] + v[2] * v[2] + v[3] * v[3];
                        u32x2 p; p.x = pk2(v[0], v[1]); p.y = pk2(v[2], v[3]); *(u32x2*)(bp + bj * 128 + n * 16) = p;
                        if (X) __builtin_nontemporal_store(v, (f32x4*)(X + (size_t)r * DM + col0 + bj * 128 + n * 16)); }
                ssq += shx(ssq, 16); ssq += shx(ssq, 32);
                if (fq == 0) atomicAdd(SS + r, to_fix(ssq, SS_SCALE));
            }
    }
};

template <class Epi> DI void run_gemm(unsigned char* smem, const bf16_t* A, const bf16_t* Bt, int M, int N, int K, const Epi& E, int wv) {
    pg8::Gemm g; g.A = A; g.Bt = Bt; g.M = M; g.N = N; g.K = K; g.wv = wv;
    pg8::StaticOrder S; S.init(M, N, (int)gridDim.x, (int)blockIdx.x);
    pg8::gemm_phase<Epi, pg8::StaticOrder, false>((PG8_LAS unsigned char*)smem, g, S, E, nullptr);
}

struct TG { const float* src; const float* g; bf16_t* dst; int ldsrc, sc, nv, k0, ldd, n0; };
DI TG decode_tg(const Args& a, int it) {
    constexpr int PER_LAYER = 29 * 32 + 8 * 32 + 44 * 32 + 8 * 88;
    const int l = it / PER_LAYER; int r = it % PER_LAYER; TG t;
    if (r < 29 * 32) { const int kt = r / 29, gi = r % 29;
        if (gi < 16) { t.sc = gi * 256; t.nv = 256; } else if (gi < 28) { t.sc = gi * 256 + 8; t.nv = 256; } else { t.sc = 4096; t.nv = 8; }
        t.src = a.w_in + (size_t)l * DM * DIN_SRC; t.ldsrc = DIN_SRC; t.k0 = kt * 64; t.g = a.norm_mix + l * DM; t.dst = (bf16_t*)(a.ws + O_WIN + l * SZ_WIN); t.ldd = DM; t.n0 = gi * 256;
    } else if ((r -= 29 * 32) < 8 * 32) { const int kt = r / 8, gi = r % 8;
        t.src = a.w_out + (size_t)l * DM * DM; t.ldsrc = DM; t.sc = gi * 256; t.nv = 256; t.k0 = kt * 64; t.g = nullptr; t.dst = (bf16_t*)(a.ws + O_WOUT + l * SZ_WOUT); t.ldd = DM; t.n0 = gi * 256;
    } else if ((r -= 8 * 32) < 44 * 32) { const int kt = r / 44, gi = r % 44;
        t.src = a.w_up + (size_t)l * DM * DFF2; t.ldsrc = DFF2; t.sc = gi * 256; t.nv = 256; t.k0 = kt * 64; t.g = a.norm_ffn + l * DM; t.dst = (bf16_t*)(a.ws + O_WUP + l * SZ_WUP); t.ldd = DM; t.n0 = gi * 256;
    } else { r -= 44 * 32; const int kt = r / 8, gi = r % 8;
        t.src = a.w_down + (size_t)l * DFF * DM; t.ldsrc = DM; t.sc = gi * 256; t.nv = 256; t.k0 = kt * 64; t.g = nullptr; t.dst = (bf16_t*)(a.ws + O_WD + l * SZ_WD); t.ldd = DFF; t.n0 = gi * 256; }
    return t;
}
DI void tg_load(const TG& t, int tid, f32x4 (&v)[8], float (&gv)[8]) {
    const int c4 = (tid & 63) * 4, kr = tid >> 6;
#pragma unroll
    for (int i = 0; i < 8; ++i) { v[i] = (f32x4){0.f, 0.f, 0.f, 0.f}; if (c4 < t.nv) v[i] = __builtin_nontemporal_load((const f32x4*)(t.src + (size_t)(t.k0 + kr + 8 * i) * t.ldsrc + t.sc + c4));
        gv[i] = t.g ? t.g[t.k0 + kr + 8 * i] : 1.0f; }
}

DI int t5_bucket(int d) {
    if (d < 16) return d;
    const float ratio = (float)d / 16.0f;
    int large = 16 + (int)(logf(ratio) / 4.852030263919617f * 16.0f);
    return large < 31 ? large : 31;
}

DI void phase0(const Args& a, unsigned char* smem) {
    float* tile = (float*)smem;
    const int tid = otid();
    constexpr int PER_LAYER = 29 * 32 + 8 * 32 + 44 * 32 + 8 * 88;
    constexpr int NTILES = 4 * PER_LAYER, NX = 1024;
    {
        f32x4 v[8]; float gv[8]; TG cur, nx;
        int it = blockIdx.x;
        if (it < NTILES) { cur = decode_tg(a, NTILES - 1 - it); tg_load(cur, tid, v, gv); }
#pragma unroll 1
        for (; it < NTILES; it += gridDim.x) {
            { const int c4 = (tid & 63) * 4, kr = tid >> 6;
#pragma unroll
              for (int i = 0; i < 8; ++i) { const f32x4 vv = v[i] * gv[i]; float* tp = tile + (kr + 8 * i) * 260 + c4; *(f32x4*)tp = vv; } }
            const int nxt = it + gridDim.x;
            nx = cur;
            if (nxt < NTILES) { nx = decode_tg(a, NTILES - 1 - nxt); tg_load(nx, tid, v, gv); }
            bar_lds();
            { const int n = tid >> 1, kh = (tid & 1) * 32;
#pragma unroll
              for (int q = 0; q < 4; ++q) { float f[8];
#pragma unroll
                  for (int j = 0; j < 8; ++j) f[j] = tile[(kh + q * 8 + j) * 260 + n];
                  *(u32x4*)(cur.dst + (size_t)(cur.n0 + n) * cur.ldd + cur.k0 + kh + q * 8) = pack8(f); } }
            bar_lds();
            cur = nx;
        }
    }
    for (int it = blockIdx.x; it < NX; it += gridDim.x) {
        {
            const int row = it * 8 + (tid >> 6), lane = tid & 63;
            const float* xp = a.x + (size_t)row * DM; bf16_t* bp = (bf16_t*)(a.ws + O_XB) + (size_t)row * DM;
            float ssq = 0.f;
#pragma unroll
            for (int i = 0; i < 8; ++i) { const int c = (i * 64 + lane) * 4; const f32x4 v = __builtin_nontemporal_load((const f32x4*)(xp + c));
                ssq += v[0] * v[0] + v[1] * v[1] + v[2] * v[2] + v[3] * v[3]; u32x2 p; p.x = pk2(v[0], v[1]); p.y = pk2(v[2], v[3]); *(u32x2*)(bp + c) = p; }
#pragma unroll
            for (int o = 1; o < 64; o <<= 1) ssq += shx(ssq, o);
            if (lane == 0) ((u64*)(a.ws + O_SS))[row] = to_fix(ssq, SS_SCALE);
        }
    }
    const int gt = blockIdx.x * 512 + tid, gn = gridDim.x * 512;
    u64* ss = (u64*)(a.ws + O_SS);
    { const u64 z0 = (u64)((unsigned)tid >> 31); for (int i = gt; i < 8 * T_TOK; i += gn) ss[T_TOK + i] = z0; }
    float* bt = (float*)(a.ws + O_BIAST);
    for (int i = gt; i < 8 * 2048; i += gn) { const int h = i >> 11, d = i & 2047; bt[i] = a.rel_bias[t5_bucket(d) * 8 + h] * 1.4426950408889634f; }
}

DI void prep_mlstm_item(const Args& a, int l, int item, unsigned char* smem) {
    const int bh = item >> 5, c = item & 31, b = bh >> 2, h = bh & 3, tid = otid();
    const bf16_t* z = (const bf16_t*)(a.ws + O_Z);
    bf16_t* tileK = (bf16_t*)smem; bf16_t* tileV = (bf16_t*)(smem + 64 * 264 * 2);
    const int cg8 = tid & 31, rg = tid >> 5;
    const size_t trow0 = (size_t)b * SEQ + c * 64;
    u32x4 zr[2][7], vr[4]; f32x4 wv[2][4][2], bv[2][2];
#pragma unroll
    for (int part = 0; part < 2; ++part) { const int ch0 = part * 1024 + h * 256 + cg8 * 8;
#pragma unroll
        for (int i = 0; i < 7; ++i) { const int sl = c * 64 + rg * 4 - 3 + i; zr[part][i] = (u32x4){0u, 0u, 0u, 0u}; if (sl >= 0) zr[part][i] = __builtin_nontemporal_load((const u32x4*)(z + ((size_t)b * SEQ + sl) * ZLD + ch0)); } }
    { const int row = tid >> 3, seg = tid & 7;
#pragma unroll
      for (int i = 0; i < 4; ++i) vr[i] = __builtin_nontemporal_load((const u32x4*)(z + (trow0 + row) * ZLD + 2048 + h * 256 + seg * 8 + i * 64)); }
#pragma unroll
    for (int part = 0; part < 2; ++part) { const int ch0 = part * 1024 + h * 256 + cg8 * 8;
        const float* cw = a.conv_qk_w + (size_t)l * 4 * 2048 + ch0; const float* cb = a.conv_qk_b + (size_t)l * 2048 + ch0;
#pragma unroll
        for (int j = 0; j < 4; ++j) { wv[part][j][0] = *(const f32x4*)(cw + j * 2048); wv[part][j][1] = *(const f32x4*)(cw + j * 2048 + 4); }
        bv[part][0] = *(const f32x4*)cb; bv[part][1] = *(const f32x4*)(cb + 4); }
    __syncthreads();
    { const int row = tid >> 3, seg = tid & 7;
#pragma unroll
      for (int i = 0; i < 4; ++i) *(u32x4*)(tileV + row * 264 + seg * 8 + i * 64) = vr[i]; }
#pragma unroll
    for (int part = 0; part < 2; ++part) {
        float xin[7][8];
#pragma unroll
        for (int i = 0; i < 7; ++i) unpack8(zr[part][i], xin[i]);
        bf16_t* dst = (bf16_t*)(a.ws + (part == 0 ? O_QC : O_KC));
        const float osc = part == 0 ? 0.0625f : 1.0f;
#pragma unroll
        for (int o = 0; o < 4; ++o) { float y[8];
#pragma unroll
            for (int e = 0; e < 8; ++e) { float s_ = bv[part][e >> 2][e & 3];
#pragma unroll
                for (int j = 0; j < 4; ++j) s_ += wv[part][j][e >> 2][e & 3] * xin[o + j][e];
                y[e] = siluf_(s_) * osc; }
            const u32x4 pk = pack8(y);
            *(u32x4*)(dst + (trow0 + rg * 4 + o) * 1024 + h * 256 + cg8 * 8) = pk;
            if (part == 1) *(u32x4*)(tileK + (rg * 4 + o) * 264 + cg8 * 8) = pk; }
    }
    bar_lds();
    { const int d = tid >> 1, sh = tid & 1;
      bf16_t* kT = (bf16_t*)(a.ws + O_KT) + ((size_t)(bh * 32 + c) * 256 + d) * 64 + sh * 32;
      bf16_t* vT = (bf16_t*)(a.ws + O_VT) + ((size_t)(bh * 32 + c) * 256 + d) * 64 + sh * 32;
#pragma unroll
      for (int i = 0; i < 4; ++i) { unsigned w1[4], w2[4];
#pragma unroll
          for (int j = 0; j < 4; ++j) { const int s_ = sh * 32 + i * 8 + j * 2;
              w1[j] = (unsigned)tileK[s_ * 264 + d] | ((unsigned)tileK[(s_ + 1) * 264 + d] << 16);
              w2[j] = (unsigned)tileV[s_ * 264 + d] | ((unsigned)tileV[(s_ + 1) * 264 + d] << 16); }
          u32x4 v1, v2; v1.x = w1[0]; v1.y = w1[1]; v1.z = w1[2]; v1.w = w1[3]; v2.x = w2[0]; v2.y = w2[1]; v2.z = w2[2]; v2.w = w2[3];
          *(u32x4*)(kT + i * 8) = v1; *(u32x4*)(vT + i * 8) = v2; } }
    bar_lds();
}

DI void prep_attn_item(const Args& a, int l, int item, unsigned char* smem) {
    const int b = item >> 6, blk = (item >> 3) & 7, head = item & 7, tid = otid();
    const bf16_t* z = (const bf16_t*)(a.ws + O_Z);
    bf16_t* tile = (bf16_t*)smem;
    float* part = (float*)(smem + 256 * 136 * 2);
    const int lr = tid >> 4, cgp = tid & 15;
    const size_t t0 = (size_t)b * SEQ + blk * 256;
    float g0[8], g1[8], colsum[8];
    { const float* gp = a.qk_norm + (size_t)l * 256 + cgp * 8;
#pragma unroll
      for (int e = 0; e < 8; ++e) { g0[e] = gp[e] * (0.08838834764831845f * 1.4426950408889634f); g1[e] = gp[128 + e]; colsum[e] = 0.f; } }
    bf16_t* aqn = (bf16_t*)(a.ws + O_AQN); bf16_t* akn = (bf16_t*)(a.ws + O_AKN);
#pragma unroll 1
    for (int pb = 0; pb < 2; ++pb) {
        u32x4 rq[4], rk[4], rv[4];
#pragma unroll
        for (int pp = 0; pp < 4; ++pp) { const int r = (pb * 4 + pp) * 32 + lr; const bf16_t* zr = z + (t0 + r) * ZLD + head * 128 + cgp * 8;
            rq[pp] = __builtin_nontemporal_load((const u32x4*)(zr + 4096)); rk[pp] = __builtin_nontemporal_load((const u32x4*)(zr + 5120)); rv[pp] = __builtin_nontemporal_load((const u32x4*)(zr + 6144)); }
#pragma unroll
        for (int pp = 0; pp < 4; ++pp) { const int r = (pb * 4 + pp) * 32 + lr;
            float f[8], y[8];
            { unpack8(rq[pp], f); float ssq = 0.f;
#pragma unroll
              for (int e = 0; e < 8; ++e) ssq += f[e] * f[e];
              ssq += shx(ssq, 1); ssq += shx(ssq, 2); ssq += shx(ssq, 4); ssq += shx(ssq, 8);
              const float rstd = rsqrtf(ssq * (1.0f / 128.0f) + EPS);
#pragma unroll
              for (int e = 0; e < 8; ++e) y[e] = f[e] * rstd * g0[e];
              *(u32x4*)(aqn + (t0 + r) * 1024 + head * 128 + cgp * 8) = pack8(y); }
            { unpack8(rk[pp], f); float ssq = 0.f;
#pragma unroll
              for (int e = 0; e < 8; ++e) ssq += f[e] * f[e];
              ssq += shx(ssq, 1); ssq += shx(ssq, 2); ssq += shx(ssq, 4); ssq += shx(ssq, 8);
              const float rstd = rsqrtf(ssq * (1.0f / 128.0f) + EPS);
#pragma unroll
              for (int e = 0; e < 8; ++e) { y[e] = f[e] * rstd * g1[e]; colsum[e] += y[e]; }
              *(u32x4*)(akn + (t0 + r) * 1024 + head * 128 + cgp * 8) = pack8(y); }
            *(u32x4*)(tile + r * 136 + cgp * 8) = rv[pp]; }
    }
#pragma unroll
    for (int e = 0; e < 8; ++e) part[lr * 128 + cgp * 8 + e] = colsum[e];
    __syncthreads();
    if (tid < 128) { float s = 0.f;
#pragma unroll 8
        for (int i = 0; i < 32; ++i) s += part[i * 128 + tid];
        ((float*)(a.ws + O_KMEAN))[((size_t)(b * 8 + head) * 8 + blk) * 128 + tid] = s * (1.0f / 256.0f); }
    { const int d = tid >> 2, seg = tid & 3; bf16_t* vT = (bf16_t*)(a.ws + O_AVT) + ((size_t)(b * 8 + head) * 128 + d) * SEQ + blk * 256 + seg * 64;
#pragma unroll
      for (int i = 0; i < 8; ++i) { unsigned wv[4];
#pragma unroll
          for (int j = 0; j < 4; ++j) { const int r = seg * 64 + i * 8 + j * 2; wv[j] = (unsigned)tile[r * 136 + d] | ((unsigned)tile[(r + 1) * 136 + d] << 16); }
          u32x4 v; v.x = wv[0]; v.y = wv[1]; v.z = wv[2]; v.w = wv[3]; *(u32x4*)(vT + i * 8) = v; } }
    __syncthreads();
}

DI void prep_gate_item(const Args& a, int l, int bh, unsigned char* smem) {
    const int tid = otid(), w = tid >> 6, lane = tid & 63, b = bh >> 2, h = bh & 3;
    float* gl = (float*)smem;
    const float* gates = (const float*)(a.ws + O_GATES); float* gsc = (float*)(a.ws + O_GSC); float* ach = (float*)(a.ws + O_ACH);
    const float bi = a.gate_bias[l * 8 + h], bf = a.gate_bias[l * 8 + 4 + h];
    float u_[4], bs_[4], cm_[4];
#pragma unroll
    for (int i = 0; i < 4; ++i) { const int c = w * 4 + i; const size_t t = (size_t)b * SEQ + c * 64 + lane;
        const float li = gates[t * 8 + h] + bi, xf = gates[t * 8 + 4 + h] + bf;
        const float lf = fminf(xf, 0.f) - log1pf(expf(-fabsf(xf)));
        float bs = lf;
#pragma unroll
        for (int o = 1; o < 64; o <<= 1) { const float v = shu(bs, o); if (lane >= o) bs += v; }
        const float u = li - bs; float cm = u;
#pragma unroll
        for (int o = 1; o < 64; o <<= 1) { const float v = shu(cm, o); if (lane >= o) cm = fmaxf(cm, v); }
        u_[i] = u; bs_[i] = bs; cm_[i] = cm;
        if (lane == 63) { gl[c] = bs; gl[32 + c] = cm; } }
    __syncthreads();
    if (tid == 0) { float m = 0.f;
#pragma unroll 1
        for (int c = 0; c < 32; ++c) { gl[64 + c] = m; m = gl[c] + fmaxf(m, gl[32 + c]); } }
    __syncthreads();
#pragma unroll
    for (int i = 0; i < 4; ++i) { const int c = w * 4 + i; const float m = gl[64 + c];
        const float M = fmaxf(m, cm_[i]), W = expf(m - M), F = expf(-(bs_[i] + M)), M63 = fmaxf(m, gl[32 + c]);
        const size_t o = (size_t)bh * SEQ + c * 64 + lane;
        gsc[o] = u_[i]; gsc[32768 + o] = M; gsc[65536 + o] = W; gsc[98304 + o] = F; gsc[131072 + o] = expf(u_[i] - M63);
        if (lane == 0) ach[bh * 32 + c] = expf(m - M63); }
    __syncthreads();
}

DI void phase_prep(const Args& a, int l, unsigned char* smem) {
    for (int it = blockIdx.x; it < 512 + 256 + 16; it += gridDim.x) {
        if (it < 512) { const int i = it & 255, xcd = i & 7, slot = i >> 3, bh = xcd * 2 + (slot >> 4), c = (slot & 15) + 16 * (it >> 8); prep_mlstm_item(a, l, bh * 32 + c, smem); }
        else if (it < 768) { const int i = it - 512, xcd = i & 7, slot = i >> 3, bh = xcd * 4 + (slot >> 3), blk = slot & 7; prep_attn_item(a, l, (bh >> 3) * 64 + blk * 8 + (bh & 7), smem); }
        else { const int i = it - 768; prep_gate_item(a, l, (i & 7) * 2 + (i >> 3), smem); }
    }
}

DI void mlstm_item(const Args& a, int item, unsigned char* smem) {
    const int bh = item >> 4, es = item & 15, b = bh >> 2, h = bh & 3, e0 = es * 16;
    const int tid = otid(), w = tid >> 6, lane = tid & 63, fr = lane & 15, fq = lane >> 4;
    float* nst = (float*)smem;
    float* gU = (float*)(smem + 32768); float* gM = gU + 2048; float* gW = gM + 2048; float* gF = gW + 2048; float* gWK = gF + 2048; float* adecs = gWK + 2048;
    const bf16_t* qc = (const bf16_t*)(a.ws + O_QC); const bf16_t* kc = (const bf16_t*)(a.ws + O_KC);
    const bf16_t* kT = (const bf16_t*)(a.ws + O_KT); const bf16_t* vT = (const bf16_t*)(a.ws + O_VT);
    const float* gsc = (const float*)(a.ws + O_GSC); const float* ach = (const float*)(a.ws + O_ACH);
    float* NS = (float*)(a.ws + O_NS);
    bf16_t* CS = (bf16_t*)(a.ws + O_CS) + (size_t)item * 32 * 4096;
    __syncthreads();
    for (int i = tid; i < 2048; i += 512) { const size_t o = (size_t)bh * SEQ + i; gWK[i] = gsc[131072 + o]; }
    if (tid < 32) adecs[tid] = ach[bh * 32 + tid];
    __syncthreads();
    {
        f32x4 accC[2]; accC[0] = (f32x4){0.f, 0.f, 0.f, 0.f}; accC[1] = accC[0]; float nacc[2] = {0.f, 0.f};
        const bf16_t* ktp = kT + ((size_t)(bh * 32) * 256 + (2 * w) * 16 + fr) * 64 + fq * 8;
        const bf16_t* vtp = vT + ((size_t)(bh * 32) * 256 + e0 + fr) * 64 + fq * 8;
        bf16x8 rk[4][4], rv[4][2];
#define LA_LOAD(set, cc) do { _Pragma("unroll") for (int i_ = 0; i_ < 2; ++i_) _Pragma("unroll") for (int k_ = 0; k_ < 2; ++k_) rk[set][i_ * 2 + k_] = *(const bf16x8*)(ktp + (size_t)(cc) * 16384 + i_ * 1024 + k_ * 32); \
        _Pragma("unroll") for (int k_ = 0; k_ < 2; ++k_) rv[set][k_] = *(const bf16x8*)(vtp + (size_t)(cc) * 16384 + k_ * 32); } while (0)
        LA_LOAD(0, 0); LA_LOAD(1, 1); LA_LOAD(2, 2); LA_LOAD(3, 3);
#pragma unroll
        for (int c0 = 0; c0 < 32; c0 += 4) {
#pragma unroll
            for (int j = 0; j < 4; ++j) { const int c = c0 + j;
                if (c < 31) {
                    const float adec = adecs[c];
                    bf16x8 vw[2]; float wk[2][8];
#pragma unroll
                    for (int kk = 0; kk < 2; ++kk) { const f32x4 w0 = *(const f32x4*)(gWK + c * 64 + kk * 32 + fq * 8), w1 = *(const f32x4*)(gWK + c * 64 + kk * 32 + fq * 8 + 4);
                        wk[kk][0] = w0[0]; wk[kk][1] = w0[1]; wk[kk][2] = w0[2]; wk[kk][3] = w0[3]; wk[kk][4] = w1[0]; wk[kk][5] = w1[1]; wk[kk][6] = w1[2]; wk[kk][7] = w1[3];
                        float f[8]; unpack8(__builtin_bit_cast(u32x4, rv[j][kk]), f);
#pragma unroll
                        for (int e = 0; e < 8; ++e) f[e] *= wk[kk][e];
                        vw[kk] = __builtin_bit_cast(bf16x8, pack8(f)); }
#pragma unroll
                    for (int i = 0; i < 2; ++i) { f32x4 acc = accC[i] * adec;
#pragma unroll
                        for (int kk = 0; kk < 2; ++kk) acc = MFMA16(rk[j][i * 2 + kk], vw[kk], acc);
                        accC[i] = acc;
                        u32x2 pw; pw.x = pk2(acc[0], acc[1]); pw.y = pk2(acc[2], acc[3]);
                        *(u32x2*)(CS + (size_t)(c + 1) * 4096 + fr * 256 + (2 * w + i) * 16 + 4 * fq) = pw;
                        if (2 * w + i == es) {
                            float ns = 0.f;
#pragma unroll
                            for (int kk = 0; kk < 2; ++kk) { float f[8]; unpack8(__builtin_bit_cast(u32x4, rk[j][i * 2 + kk]), f);
#pragma unroll
                                for (int e = 0; e < 8; ++e) ns += f[e] * wk[kk][e]; }
                            ns += shx(ns, 16); ns += shx(ns, 32); nacc[i] = adec * nacc[i] + ns;
                            if (fq == 0) NS[(size_t)(bh * 32 + c + 1) * 256 + (2 * w + i) * 16 + fr] = nacc[i]; } }
                }
                if (c + 4 < 31) LA_LOAD(j, c + 4);
            }
        }
#undef LA_LOAD
    }
}

constexpr int MO_QS = 0, MO_KS = 34816, MO_PS = 69632, MO_RSP = 79872, MO_QN = 80896, MO_HSQ = 81152, MO_NL = 83200, MO_SCL = 84224;
DI void mlstm_out_item(const Args& a, int l, int item, unsigned char* smem) {
    const int bh = item >> 5, c = item & 31, b = bh >> 2, h = bh & 3;
    const int tid = otid(), w = tid >> 6, lane = tid & 63, fr = lane & 15, fq = lane >> 4;
    bf16_t* Qs = (bf16_t*)(smem + MO_QS); bf16_t* Ks = (bf16_t*)(smem + MO_KS); bf16_t* Ps = (bf16_t*)(smem + MO_PS);
    float* rsp = (float*)(smem + MO_RSP); float* qnv = (float*)(smem + MO_QN); float* hsq = (float*)(smem + MO_HSQ); float* nloc = (float*)(smem + MO_NL); float* scl = (float*)(smem + MO_SCL);
    const bf16_t* qc = (const bf16_t*)(a.ws + O_QC); const bf16_t* kc = (const bf16_t*)(a.ws + O_KC); const bf16_t* vT = (const bf16_t*)(a.ws + O_VT);
    const float* gsc = (const float*)(a.ws + O_GSC); const bf16_t* CS = (const bf16_t*)(a.ws + O_CS); const float* NS = (const float*)(a.ws + O_NS);
    const size_t tb = (size_t)b * SEQ + c * 64;
    __syncthreads();
    { const int qrow = tid >> 3, qseg = tid & 7; u32x4 pq[4], pk[4];
#pragma unroll
      for (int i = 0; i < 4; ++i) { pq[i] = __builtin_nontemporal_load((const u32x4*)(qc + (tb + qrow) * 1024 + h * 256 + (qseg + 8 * i) * 8)); pk[i] = __builtin_nontemporal_load((const u32x4*)(kc + (tb + qrow) * 1024 + h * 256 + (qseg + 8 * i) * 8)); }
      { const unsigned z0 = (unsigned)tid >> 31; u32x4 zz; zz.x = z0; zz.y = z0; zz.z = z0; zz.w = z0;
        for (int i = tid; i < 640; i += 512) ((u32x4*)Ps)[i] = zz; }
      if (tid < 256) nloc[tid] = (c > 0) ? NS[(size_t)(bh * 32 + c) * 256 + tid] : 0.f;
      else scl[tid - 256] = gsc[(size_t)((tid - 256) >> 6) * 32768 + (size_t)bh * SEQ + c * 64 + (tid & 63)];
#pragma unroll
      for (int i = 0; i < 4; ++i) { *(u32x4*)(Qs + qrow * 272 + (qseg + 8 * i) * 8) = pq[i]; *(u32x4*)(Ks + qrow * 272 + (qseg + 8 * i) * 8) = pk[i]; } }
    bf16x8 cf[2][8], vtf[2][2];
#pragma unroll
    for (int i = 0; i < 2; ++i) {
        const bf16_t* cp = CS + ((size_t)((bh * 16 + 2 * w + i) * 32 + c)) * 4096 + fr * 256 + fq * 8;
#pragma unroll
        for (int kk = 0; kk < 8; ++kk) cf[i][kk] = (c > 0) ? __builtin_nontemporal_load((const bf16x8*)(cp + kk * 32)) : (bf16x8){0, 0, 0, 0, 0, 0, 0, 0};
        const bf16_t* vp = vT + ((size_t)(bh * 32 + c) * 256 + 32 * w + 16 * i + fr) * 64 + fq * 8;
#pragma unroll
        for (int kk = 0; kk < 2; ++kk) vtf[i][kk] = *(const bf16x8*)(vp + kk * 32); }
    const bf16_t* z = (const bf16_t*)(a.ws + O_Z); bf16_t* mix = (bf16_t*)(a.ws + O_MIX); const float* gn = a.mlstm_norm + (size_t)l * 1024 + h * 256;
    u32x2 mo2[4][2]; f32x4 g4[2];
#pragma unroll
    for (int i = 0; i < 2; ++i) { const int e = 32 * w + 16 * i + 4 * fq; g4[i] = *(const f32x4*)(gn + e);
#pragma unroll
        for (int rt = 0; rt < 4; ++rt) mo2[rt][i] = __builtin_nontemporal_load((const u32x2*)(z + (tb + rt * 16 + fr) * ZLD + 3072 + h * 256 + e)); }
    bar_lds();
#pragma unroll 1
    for (int ti = w; ti < 10; ti += 8) {
        const int rt = ti < 1 ? 0 : ti < 3 ? 1 : ti < 6 ? 2 : 3, ct = ti - (rt * (rt + 1)) / 2;
        bf16x8 qf[8], kf[8];
#pragma unroll
        for (int kk = 0; kk < 8; ++kk) { qf[kk] = *(const bf16x8*)(Qs + (rt * 16 + fr) * 272 + kk * 32 + fq * 8); kf[kk] = *(const bf16x8*)(Ks + (ct * 16 + fr) * 272 + kk * 32 + fq * 8); }
        f32x4 sacc = {0.f, 0.f, 0.f, 0.f};
#pragma unroll
        for (int kk = 0; kk < 8; ++kk) sacc = MFMA16(kf[kk], qf[kk], sacc);
        const int t = rt * 16 + fr, s0 = ct * 16 + 4 * fq;
        const f32x4 us = *(const f32x4*)(scl + s0); const float Mt = scl[64 + t];
        float p[4], rs = 0.f;
#pragma unroll
        for (int j = 0; j < 4; ++j) { p[j] = (s0 + j <= t) ? sacc[j] * __expf(us[j] - Mt) : 0.f; rs += p[j]; }
        rs += shx(rs, 16); rs += shx(rs, 32);
        if (fq == 0) rsp[(rt * 4 + ct) * 16 + fr] = rs;
        u32x2 pw; pw.x = pk2(p[0], p[1]); pw.y = pk2(p[2], p[3]); *(u32x2*)(Ps + t * 80 + s0) = pw;
    }
    { const int t = tid >> 3, pr = tid & 7; float dsum = 0.f;
#pragma unroll
      for (int i = 0; i < 4; ++i) { float f[8]; unpack8(*(const u32x4*)(Qs + t * 272 + i * 64 + pr * 8), f);
          const f32x4 n0 = *(const f32x4*)(nloc + i * 64 + pr * 8), n1 = *(const f32x4*)(nloc + i * 64 + pr * 8 + 4);
          dsum += f[0] * n0[0] + f[1] * n0[1] + f[2] * n0[2] + f[3] * n0[3] + f[4] * n1[0] + f[5] * n1[1] + f[6] * n1[2] + f[7] * n1[3]; }
      dsum += shx(dsum, 1); dsum += shx(dsum, 2); dsum += shx(dsum, 4);
      if (pr == 0) qnv[t] = dsum; }
    bar_lds();
    f32x4 hv[4][2];
#pragma unroll
    for (int rt = 0; rt < 4; ++rt) {
        bf16x8 qf[8], pf[2];
#pragma unroll
        for (int kk = 0; kk < 8; ++kk) qf[kk] = *(const bf16x8*)(Qs + (rt * 16 + fr) * 272 + kk * 32 + fq * 8);
#pragma unroll
        for (int kk = 0; kk < 2; ++kk) pf[kk] = *(const bf16x8*)(Ps + (rt * 16 + fr) * 80 + kk * 32 + fq * 8);
        const int t = rt * 16 + fr;
        const float Wt = scl[128 + t], Ft = scl[192 + t];
        float rowsum = 0.f;
#pragma unroll
        for (int ct = 0; ct < 4; ++ct) if (ct <= rt) rowsum += rsp[(rt * 4 + ct) * 16 + fr];
        const float den = Wt * qnv[t] + rowsum, inv = 1.0f / fmaxf(fabsf(den), Ft);
        float hs = 0.f;
#pragma unroll
        for (int i = 0; i < 2; ++i) { f32x4 a1 = {0.f, 0.f, 0.f, 0.f}, a2 = {0.f, 0.f, 0.f, 0.f};
#pragma unroll
            for (int kk = 0; kk < 8; ++kk) a1 = MFMA16(cf[i][kk], qf[kk], a1);
#pragma unroll
            for (int kk = 0; kk < 2; ++kk) a2 = MFMA16(vtf[i][kk], pf[kk], a2);
#pragma unroll
            for (int j = 0; j < 4; ++j) { const float v = (Wt * a1[j] + a2[j]) * inv; hv[rt][i][j] = v; hs += v * v; } }
        hs += shx(hs, 16); hs += shx(hs, 32);
        if (fq == 0) hsq[w * 64 + t] = hs;
    }
    bar_lds();
#pragma unroll
    for (int rt = 0; rt < 4; ++rt) {
        const int t = rt * 16 + fr; float tot = 0.f;
#pragma unroll
        for (int ww = 0; ww < 8; ++ww) tot += hsq[ww * 64 + t];
        const float rstd = rsqrtf(tot * (1.0f / 256.0f) + EPS);
#pragma unroll
        for (int i = 0; i < 2; ++i) { const int e = 32 * w + 16 * i + 4 * fq;
            const u32x2 mo = mo2[rt][i]; const f32x4 gg = g4[i];
            const float y0 = hv[rt][i][0] * rstd * gg[0] * sigmoidf_(bflo(mo.x)), y1 = hv[rt][i][1] * rstd * gg[1] * sigmoidf_(bfhi(mo.x));
            const float y2 = hv[rt][i][2] * rstd * gg[2] * sigmoidf_(bflo(mo.y)), y3 = hv[rt][i][3] * rstd * gg[3] * sigmoidf_(bfhi(mo.y));
            u32x2 pw; pw.x = pk2(y0, y1); pw.y = pk2(y2, y3); *(u32x2*)(mix + (tb + t) * DM + h * 256 + e) = pw; }
    }
}

DI void phase_mlstm_out(const Args& a, int l, unsigned char* smem) {
    for (int it = blockIdx.x; it < 512; it += gridDim.x) { const int i = it & 255, xcd = i & 7, slot = i >> 3, bh = xcd * 2 + (slot >> 4), c = (slot & 15) + 16 * (it >> 8); mlstm_out_item(a, l, bh * 32 + c, smem); }
}

constexpr int AT_K = 0, AT_V = 36864, AT_P = 77824, AT_BIAS = 118784, AT_KM = 126976;

DI void attn_item(const Args& a, int b, int head, int qt, unsigned char* smem) {
    const int tid = otid(), w = tid >> 6, lane = tid & 63, fr = lane & 15, fq = lane >> 4;
    const int bh = b * 8 + head, qblk = qt >> 1, q0 = qt * 128 + w * 16;
    bf16_t* Kt = (bf16_t*)(smem + AT_K); bf16_t* Vt = (bf16_t*)(smem + AT_V); bf16_t* Pw = (bf16_t*)(smem + AT_P) + w * 2 * 16 * 80;
    float* biasTab = (float*)(smem + AT_BIAS); float* km = (float*)(smem + AT_KM);
    const bf16_t* aqn = (const bf16_t*)(a.ws + O_AQN); const bf16_t* akn = (const bf16_t*)(a.ws + O_AKN); const bf16_t* avT = (const bf16_t*)(a.ws + O_AVT);
    __syncthreads();
    for (int i = tid; i < 2048; i += 512) biasTab[i] = ((const float*)(a.ws + O_BIAST))[head * 2048 + i];
    for (int i = tid; i < 1024; i += 512) km[i] = ((const float*)(a.ws + O_KMEAN))[(size_t)bh * 1024 + i];
    bf16x8 qf[4];
    { const bf16_t* qp = aqn + ((size_t)b * SEQ + q0 + fr) * 1024 + head * 128 + fq * 8;
#pragma unroll
      for (int kk = 0; kk < 4; ++kk) qf[kk] = __builtin_nontemporal_load((const bf16x8*)(qp + kk * 32)); }
    const int krow = tid >> 3, kseg = tid & 7, vd = tid >> 2, vseg = tid & 3;
    u32x4 pkA[2], pvA[2], pkB[2], pvB[2];
#define AT_LOAD(PK, PV, kt) do { _Pragma("unroll") for (int i = 0; i < 2; ++i) { \
        PK[i] = *(const u32x4*)(akn + ((size_t)b * SEQ + (kt) * 64 + krow) * 1024 + head * 128 + kseg * 8 + i * 64); \
        PV[i] = *(const u32x4*)(avT + ((size_t)bh * 128 + vd) * SEQ + (kt) * 64 + vseg * 8 + i * 32); } } while (0)
#define AT_STORE(PK, PV, buf) do { _Pragma("unroll") for (int i = 0; i < 2; ++i) { \
        *(u32x4*)(Kt + (buf) * 64 * 144 + krow * 144 + kseg * 8 + i * 64) = PK[i]; \
        *(u32x4*)(Vt + (buf) * 128 * 80 + vd * 80 + vseg * 8 + i * 32) = PV[i]; } } while (0)
    AT_LOAD(pkA, pvA, 0);
    AT_LOAD(pkB, pvB, 1);
    __syncthreads();
    unsigned selmask;
    { float g[8];
#pragma unroll
      for (int n = 0; n < 8; ++n) { float p = 0.f;
#pragma unroll
          for (int kk = 0; kk < 4; ++kk)
              { const f32x4 k0 = *(const f32x4*)(km + n * 128 + kk * 32 + fq * 8), k1 = *(const f32x4*)(km + n * 128 + kk * 32 + fq * 8 + 4);
                p += bf1((bf16_t)qf[kk][0]) * k0[0] + bf1((bf16_t)qf[kk][1]) * k0[1] + bf1((bf16_t)qf[kk][2]) * k0[2] + bf1((bf16_t)qf[kk][3]) * k0[3]
                   + bf1((bf16_t)qf[kk][4]) * k1[0] + bf1((bf16_t)qf[kk][5]) * k1[1] + bf1((bf16_t)qf[kk][6]) * k1[2] + bf1((bf16_t)qf[kk][7]) * k1[3]; }
          p += shx(p, 16); p += shx(p, 32); g[n] = p; }
      if (qblk <= 3) selmask = (1u << qblk) - 1u;
      else { selmask = 0u;
#pragma unroll
          for (int r = 0; r < 3; ++r) { float best = -INFINITY; int bi = 0;
#pragma unroll
              for (int n = 0; n < 8; ++n) if (n < qblk && !((selmask >> n) & 1u) && g[n] > best) { best = g[n]; bi = n; }
              selmask |= 1u << bi; } } }
    AT_STORE(pkA, pvA, 0);
    AT_STORE(pkB, pvB, 1);
    bar_lds();
#pragma unroll
    for (int kk = 0; kk < 4; ++kk) { u32x4 t_ = __builtin_bit_cast(u32x4, qf[kk]); asm volatile("" : "+v"(t_.x), "+v"(t_.y), "+v"(t_.z), "+v"(t_.w)); qf[kk] = __builtin_bit_cast(bf16x8, t_); }
    const int nkt = 2 * (qt + 1);
    f32x4 o[8];
#pragma unroll
    for (int i = 0; i < 8; ++i) o[i] = (f32x4){0.f, 0.f, 0.f, 0.f};
    float lrun = 0.f;
    const int qpos = q0 + fr;
    auto compute2 = [&](const int kt) __attribute__((always_inline)) {
        bool own[2], lsel[2], act[2];
#pragma unroll
        for (int u = 0; u < 2; ++u) { const int n = (kt + u) >> 2; own[u] = (n == qblk); lsel[u] = ((selmask >> n) & 1u) != 0u;
            act[u] = own[u] ? ((kt + u) * 64 <= q0 + 15) : (__ballot(lsel[u]) != 0ull); }
        if (act[0] || act[1]) {
            f32x4 s[2][4];
#pragma unroll
            for (int hf = 0; hf < 2; ++hf) { bf16x8 kf[2][8];
#pragma unroll
                for (int u = 0; u < 2; ++u)
#pragma unroll
                    for (int i = 0; i < 8; ++i) kf[u][i] = *(const bf16x8*)(Kt + u * 64 * 144 + ((hf * 2 + (i >> 2)) * 16 + fr) * 144 + (i & 3) * 32 + fq * 8);
#pragma unroll
                for (int u = 0; u < 2; ++u) { s[u][hf * 2] = (f32x4){0.f, 0.f, 0.f, 0.f}; s[u][hf * 2 + 1] = (f32x4){0.f, 0.f, 0.f, 0.f}; }
#pragma unroll
                for (int kk = 0; kk < 4; ++kk)
#pragma unroll
                    for (int u = 0; u < 2; ++u)
#pragma unroll
                        for (int c2 = 0; c2 < 2; ++c2) s[u][hf * 2 + c2] = MFMA16(kf[u][c2 * 4 + kk], qf[kk], s[u][hf * 2 + c2]); }
#pragma unroll
            for (int u = 0; u < 2; ++u) {
                float bv[16];
                const int rel0 = qpos - ((kt + u) * 64 + 4 * fq);
                { const float* bp = biasTab + (rel0 - 51);
#pragma unroll
                  for (int ct = 0; ct < 4; ++ct)
#pragma unroll
                      for (int j = 0; j < 4; ++j) bv[ct * 4 + j] = bp[51 - ct * 16 - j]; }
                float ps = 0.f; u32x2 pw[4];
                if (!own[u]) {
#pragma unroll
                    for (int ct = 0; ct < 4; ++ct) { float p[4];
#pragma unroll
                        for (int j = 0; j < 4; ++j) { p[j] = __builtin_amdgcn_exp2f(s[u][ct][j] + bv[ct * 4 + j]); ps += p[j]; }
                        pw[ct].x = pk2(p[0], p[1]); pw[ct].y = pk2(p[2], p[3]); }
                    if (!lsel[u]) { ps = 0.f;
#pragma unroll
                        for (int ct = 0; ct < 4; ++ct) { pw[ct].x = 0u; pw[ct].y = 0u; } }
                } else {
#pragma unroll
                    for (int ct = 0; ct < 4; ++ct) { float p[4];
#pragma unroll
                        for (int j = 0; j < 4; ++j) { const int rel = rel0 - ct * 16 - j; p[j] = rel >= 0 ? __builtin_amdgcn_exp2f(s[u][ct][j] + bv[ct * 4 + j]) : 0.f; ps += p[j]; }
                        pw[ct].x = pk2(p[0], p[1]); pw[ct].y = pk2(p[2], p[3]); }
                }
                lrun += ps;
#pragma unroll
                for (int ct = 0; ct < 4; ++ct) *(u32x2*)(Pw + u * 16 * 80 + fr * 80 + ct * 16 + 4 * fq) = pw[ct];
            }
            bf16x8 pf[2][2];
#pragma unroll
            for (int u = 0; u < 2; ++u) { pf[u][0] = *(const bf16x8*)(Pw + u * 16 * 80 + fr * 80 + fq * 8); pf[u][1] = *(const bf16x8*)(Pw + u * 16 * 80 + fr * 80 + 32 + fq * 8); }
#pragma unroll
            for (int dh = 0; dh < 2; ++dh) { bf16x8 vf[2][8];
#pragma unroll
                for (int u = 0; u < 2; ++u)
#pragma unroll
                    for (int i = 0; i < 8; ++i) vf[u][i] = *(const bf16x8*)(Vt + u * 128 * 80 + ((dh * 4 + (i >> 1)) * 16 + fr) * 80 + (i & 1) * 32 + fq * 8);
#pragma unroll
                for (int u = 0; u < 2; ++u)
#pragma unroll
                    for (int k2 = 0; k2 < 2; ++k2)
#pragma unroll
                        for (int dt = 0; dt < 4; ++dt) o[dh * 4 + dt] = MFMA16(vf[u][dt * 2 + k2], pf[u][k2], o[dh * 4 + dt]); }
        }
    };
#ifdef PROBE_MASK
    unsigned long long tcomp = 0ull; const unsigned long long tl0 = clock64();
#endif
#pragma unroll 1
    for (int kt = 0; kt < nkt; kt += 2) {
        if (kt + 2 < nkt) { AT_LOAD(pkA, pvA, kt + 2); AT_LOAD(pkB, pvB, kt + 3); }
#ifdef PROBE_MASK
        const unsigned long long tc0 = clock64();
#endif
        compute2(kt);
#ifdef PROBE_MASK
        const unsigned long long tc1 = clock64();
#if !defined(PROBE_SEL) || PROBE_SEL == 0
        tcomp += tc1 - tc0;
#endif
#endif
        bar_lds();
#ifdef PROBE_MASK
        const unsigned long long tc2 = clock64();
#if PROBE_SEL == 1
        tcomp += tc2 - tc1;
#endif
#endif
        if (kt + 2 < nkt) { AT_STORE(pkA, pvA, 0); AT_STORE(pkB, pvB, 1); }
#ifdef PROBE_MASK
        asm volatile("s_waitcnt lgkmcnt(0)" ::: "memory");
        const unsigned long long tc3 = clock64();
#if PROBE_SEL == 2
        tcomp += tc3 - tc2;
#endif
#endif
        bar_lds();
    }
#ifdef PROBE_MASK
    if (blockIdx.x == 0 && tid == 0) { unsigned long long* ts = (unsigned long long*)(a.ws + O_TS); ts[70] += tcomp; ts[71] += clock64() - tl0; }
#endif
    lrun += shx(lrun, 16); lrun += shx(lrun, 32);
    const float inv = 1.0f / lrun;
    bf16_t* op = (bf16_t*)(a.ws + O_MIX) + ((size_t)b * SEQ + qpos) * DM + 1024 + head * 128 + 4 * fq;
#pragma unroll
    for (int dt = 0; dt < 8; ++dt) { u32x2 pw; pw.x = pk2(o[dt][0] * inv, o[dt][1] * inv); pw.y = pk2(o[dt][2] * inv, o[dt][3] * inv); *(u32x2*)(op + dt * 16) = pw; }
#undef AT_LOAD
#undef AT_STORE
}

DI void phase_mixer(const Args& a, unsigned char* smem, int l) {
    for (int it = blockIdx.x; it < 256; it += gridDim.x) { const int xcd = it & 7, slot = it >> 3; mlstm_item(a, (xcd * 2 + (slot >> 4)) * 16 + (slot & 15), smem); }
#ifdef PROBE_MASK
    if (blockIdx.x == 0 && otid() == 0) ((unsigned long long*)(a.ws + O_TS))[64 + l] = wall_clock64();
#endif
    for (int it = blockIdx.x; it < 256; it += gridDim.x) { const int xcd = it & 7, slot = it >> 3, bh = xcd * 4 + (slot >> 3), j = slot & 7; attn_item(a, bh >> 3, bh & 7, j, smem); attn_item(a, bh >> 3, bh & 7, 15 - j, smem); }
#ifdef PROBE_MASK
    if (blockIdx.x == 0 && otid() == 0) ((unsigned long long*)(a.ws + O_TS))[80 + l] = wall_clock64();
#endif
}

DI void phase_hnorm(const Args& a, int l) {
    const float* hbuf = (const float*)(a.ws + O_HBUF); const u64* hss = (const u64*)(a.ws + O_HSS); const bf16_t* z = (const bf16_t*)(a.ws + O_Z);
    bf16_t* mix = (bf16_t*)(a.ws + O_MIX); const float* gn = a.mlstm_norm + (size_t)l * 1024;
    for (int i = blockIdx.x * 512 + otid(); i < T_TOK * 128; i += gridDim.x * 512) {
        const int t = i >> 7, c = (i & 127) * 8;
        const float rstd = rsqrtf((float)hss[(size_t)t * 4 + (c >> 8)] * (HS_INV / 256.0f) + EPS);
        const f32x4 h0 = *(const f32x4*)(hbuf + (size_t)t * 1024 + c), h1 = *(const f32x4*)(hbuf + (size_t)t * 1024 + c + 4);
        const f32x4 g0 = *(const f32x4*)(gn + c), g1 = *(const f32x4*)(gn + c + 4);
        float mo[8], y[8]; unpack8(*(const u32x4*)(z + (size_t)t * ZLD + 3072 + c), mo);
#pragma unroll
        for (int e = 0; e < 4; ++e) { y[e] = h0[e] * rstd * g0[e] * sigmoidf_(mo[e]); y[4 + e] = h1[e] * rstd * g1[e] * sigmoidf_(mo[4 + e]); }
        *(u32x4*)(mix + (size_t)t * DM + c) = pack8(y);
    }
}

DI void phase_ffnconv(const Args& a, int l) {
    const bf16_t* u = (const bf16_t*)(a.ws + O_U); bf16_t* act = (bf16_t*)(a.ws + O_ACT);
    const float* cw = a.conv_ffn_w + (size_t)l * 3 * DFF2; const float* cb = a.conv_ffn_b + (size_t)l * DFF2;
    constexpr int NCG = DFF / 8, RB = 8;
    for (int i = blockIdx.x * 512 + otid(); i < (T_TOK / RB) * NCG; i += gridDim.x * 512) {
        const int rb = i / NCG, f = (i % NCG) * 8; const int t0 = rb * RB; const bool first = (t0 % SEQ) == 0;
        u32x4 gr[RB + 2], vr[RB + 2];
#pragma unroll
        for (int r = 0; r < RB + 2; ++r) { gr[r] = (u32x4){0u, 0u, 0u, 0u}; vr[r] = gr[r];
            if (r >= 2 || !first) { const bf16_t* up = u + (size_t)(t0 - 2 + r) * DFF2 + f; gr[r] = __builtin_nontemporal_load((const u32x4*)up); vr[r] = __builtin_nontemporal_load((const u32x4*)(up + DFF)); } }
        float wg[3][8], wv[3][8], bg[8], bv[8];
#pragma unroll
        for (int j = 0; j < 3; ++j) { const f32x4 p0 = *(const f32x4*)(cw + j * DFF2 + f), p1 = *(const f32x4*)(cw + j * DFF2 + f + 4), q0 = *(const f32x4*)(cw + j * DFF2 + DFF + f), q1 = *(const f32x4*)(cw + j * DFF2 + DFF + f + 4);
#pragma unroll
            for (int e = 0; e < 4; ++e) { wg[j][e] = p0[e]; wg[j][4 + e] = p1[e]; wv[j][e] = q0[e]; wv[j][4 + e] = q1[e]; } }
        { const f32x4 p0 = *(const f32x4*)(cb + f), p1 = *(const f32x4*)(cb + f + 4), q0 = *(const f32x4*)(cb + DFF + f), q1 = *(const f32x4*)(cb + DFF + f + 4);
#pragma unroll
          for (int e = 0; e < 4; ++e) { bg[e] = p0[e]; bg[4 + e] = p1[e]; bv[e] = q0[e]; bv[4 + e] = q1[e]; } }
        float g0[8], g1[8], v0[8], v1[8];
        unpack8(gr[0], g0); unpack8(gr[1], g1); unpack8(vr[0], v0); unpack8(vr[1], v1);
#pragma unroll
        for (int r = 0; r < RB; ++r) { float g2[8], v2[8], y[8];
            unpack8(gr[r + 2], g2); unpack8(vr[r + 2], v2);
#pragma unroll
            for (int e = 0; e < 8; ++e) { const float G = bg[e] + wg[0][e] * g0[e] + wg[1][e] * g1[e] + wg[2][e] * g2[e]; const float V = bv[e] + wv[0][e] * v0[e] + wv[1][e] * v1[e] + wv[2][e] * v2[e];
                y[e] = siluf_(G) * V; g0[e] = g1[e]; g1[e] = g2[e]; v0[e] = v1[e]; v1[e] = v2[e]; }
            *(u32x4*)(act + (size_t)(t0 + r) * DFF + f) = pack8(y); }
    }
}

#define XB_TMO      128
#define XB_XCNT(j)  (256  + 64 * (j))
#define XB_XSUB(j)  (1280 + 64 * (j))
#define XB_XGEN(j)  (2304 + 64 * (j))
#define XB_TOP      3328
#define XB_TOPGEN   3392
#define XCD_BAR_WORDS 3456
#define XB_SPIN_CAP (1u << 18)

__device__ __forceinline__ unsigned xb_ld(unsigned* p)              { return __hip_atomic_load(p, __ATOMIC_RELAXED, __HIP_MEMORY_SCOPE_AGENT); }
__device__ __forceinline__ unsigned xb_add(unsigned* p, unsigned v) { return __hip_atomic_fetch_add(p, v, __ATOMIC_RELAXED, __HIP_MEMORY_SCOPE_AGENT); }
__device__ __forceinline__ unsigned xb_xcc_id() { return (unsigned)__builtin_amdgcn_s_getreg((3 << 11) | 20) & 0xFu; }
#define XB_SPIN(cond, bar) do { unsigned _sp = 0; while (cond) { __builtin_amdgcn_s_sleep(1); \
    if ((++_sp & 255u) == 0u) { if (xb_ld(&(bar)[XB_TMO])) break; if (_sp > XB_SPIN_CAP) { atomicAdd(&(bar)[XB_TMO], 1u); break; } } } } while (0)

struct XcdBarrier {
    unsigned* bar; unsigned x;
    volatile LAS unsigned* st;
};

__device__ __forceinline__ XcdBarrier xcd_barrier_post(unsigned* bar, volatile LAS unsigned* st, int tid) {
    XcdBarrier b; b.bar = bar; b.x = xb_xcc_id(); b.st = st;
    if (tid == 0) (void)xb_add(&bar[XB_XCNT(b.x)], 1u);
    return b;
}
__device__ __forceinline__ void xcd_barrier_complete(unsigned* bar, unsigned x, unsigned& nloc, unsigned& nx) {
    const unsigned G = gridDim.x * gridDim.y * gridDim.z;
    unsigned sum, cnt, mine, sp = 0u;
    for (;;) {
        sum = 0u; cnt = 0u; mine = 0u;
#pragma unroll
        for (unsigned j = 0; j < 16; ++j) { const unsigned c = xb_ld(&bar[XB_XCNT(j)]); sum += c; cnt += (c > 0u) ? 1u : 0u; mine = (j == x) ? c : mine; }
        if (sum == G) break;
        __builtin_amdgcn_s_sleep(1);
        if ((++sp & 255u) == 0u) { if (xb_ld(&bar[XB_TMO])) break; if (sp > XB_SPIN_CAP) { atomicAdd(&bar[XB_TMO], 1u); break; } }
    }
    nloc = mine > 0u ? mine : 1u; nx = cnt > 0u ? cnt : 1u;
}

__device__ __forceinline__ void xcd_barrier(const XcdBarrier& b, int tid) {
    asm volatile("s_waitcnt vmcnt(0)" ::: "memory");
    __syncthreads();
    if (tid == 0) {
        unsigned* bar = b.bar;
        __builtin_amdgcn_s_waitcnt(0);
        unsigned nloc = b.st[0], nx = b.st[1];
        if (nloc == 0u) { xcd_barrier_complete(bar, b.x, nloc, nx); b.st[0] = nloc; b.st[1] = nx; }
        const unsigned old = xb_add(&bar[XB_XSUB(b.x)], 1u);
        const unsigned gen = old / nloc;
        if (old + 1u == (gen + 1u) * nloc) {
            __builtin_amdgcn_fence(__ATOMIC_RELEASE, "agent");
            asm volatile("s_waitcnt vmcnt(0)" ::: "memory");
            const unsigned og = xb_add(&bar[XB_TOP], 1u);
            const unsigned tg = og / nx;
            if (og + 1u == (tg + 1u) * nx) xb_add(&bar[XB_TOPGEN], 1u);
            else XB_SPIN(xb_ld(&bar[XB_TOPGEN]) == tg, bar);
            __builtin_amdgcn_fence(__ATOMIC_ACQUIRE, "agent");
            xb_add(&bar[XB_XGEN(b.x)], 1u);
            asm volatile("s_waitcnt vmcnt(0)" ::: "memory");
        } else {
            XB_SPIN(xb_ld(&bar[XB_XGEN(b.x)]) == gen, bar);
            __builtin_amdgcn_fence(__ATOMIC_ACQUIRE, "agent");
            asm volatile("s_waitcnt vmcnt(0)" ::: "memory");
        }
    }
    __syncthreads();
}

__global__ void __launch_bounds__(512) mega_fwd(Args a_in) {
    Args a = a_in; a.wv = __builtin_amdgcn_readfirstlane((int)threadIdx.x >> 6);
    extern __shared__ __attribute__((aligned(16))) unsigned char smem[];
    cg::grid_group grid = cg::this_grid();
    constexpr int NPH = 1 + 8 * DEPTH;
    volatile LAS unsigned* bst = (volatile LAS unsigned*)(LAS unsigned char*)(smem + LDS_BYTES - 16);
    if (otid() < 2) bst[otid()] = 0u;
    __syncthreads();
    const XcdBarrier gbar = xcd_barrier_post((unsigned*)(a.ws + O_BAR), bst, otid());
#pragma unroll 1
    for (int ph = 0; ph < NPH; ++ph) {
        const int l = (ph - 1) >> 3, k = (ph - 1) & 7;
#ifdef PROBE_MASK
        if (blockIdx.x == 0 && otid() == 0) { ((unsigned long long*)(a.ws + O_TS))[ph] = wall_clock64(); if (ph == 0) { ((unsigned long long*)(a.ws + O_TS))[70] = 0ull; ((unsigned long long*)(a.ws + O_TS))[71] = 0ull; } }
#endif
        u64* ss = (u64*)(a.ws + O_SS);
        bf16_t* xb = (bf16_t*)(a.ws + O_XB);
        if (ph == 0) phase0(a, smem);
        else if (k == 0 || k == 5) {
            EpiScale E; const bf16_t* Bt; int N;
            if (k == 0) { E.O = (bf16_t*)(a.ws + O_Z); E.ldc = ZLD; E.SS = ss + (size_t)(2 * l) * T_TOK; E.gates = (float*)(a.ws + O_GATES); E.gate_pn = 28; Bt = (const bf16_t*)(a.ws + O_WIN + l * SZ_WIN); N = DINP; }
            else { E.O = (bf16_t*)(a.ws + O_U); E.ldc = DFF2; E.SS = ss + (size_t)(2 * l + 1) * T_TOK; E.gates = nullptr; E.gate_pn = -1; Bt = (const bf16_t*)(a.ws + O_WUP + l * SZ_WUP); N = DFF2; }
            run_gemm(smem, xb, Bt, T_TOK, N, DM, E, a.wv);
        } else if (k == 4 || k == 7) {
            EpiRes E; E.X = (k == 7 && l == DEPTH - 1) ? a.out : nullptr; E.XB = xb; const bf16_t* A; const bf16_t* Bt; int K;
            if (k == 4) { E.SS = ss + (size_t)(2 * l + 1) * T_TOK; A = (const bf16_t*)(a.ws + O_MIX); Bt = (const bf16_t*)(a.ws + O_WOUT + l * SZ_WOUT); K = DM; }
            else { E.SS = ss + (size_t)(2 * l + 2) * T_TOK; A = (const bf16_t*)(a.ws + O_ACT); Bt = (const bf16_t*)(a.ws + O_WD + l * SZ_WD); K = DFF; }
            run_gemm(smem, A, Bt, T_TOK, DM, K, E, a.wv);
        } else if (k == 1) phase_prep(a, l, smem);
        else if (k == 2) phase_mixer(a, smem, l);
        else if (k == 3) phase_mlstm_out(a, l, smem);
        else phase_ffnconv(a, l);
        if (a.ws == nullptr) grid.sync();
        if (ph + 1 < NPH) xcd_barrier(gbar, otid());
    }
#ifdef PROBE_MASK
    if (blockIdx.x == 0) {
        __syncthreads();
        float* dsh = (float*)smem;
        if (otid() == 0) {
            unsigned long long* ts = (unsigned long long*)(a.ws + O_TS); ts[NPH] = wall_clock64();
            unsigned long long sel = 0ull;
            for (int ph = 0; ph < NPH; ++ph) { const int kk = ph == 0 ? 8 : ((ph - 1) & 7); if ((PROBE_MASK >> kk) & 1) sel += ts[ph + 1] - ts[ph]; }
            if ((PROBE_MASK >> 9) & 1) for (int l = 0; l < DEPTH; ++l) sel += ts[64 + l] - ts[1 + 8 * l + 2];
            float frac = (float)sel / (float)(ts[NPH] - ts[0]);
            if ((PROBE_MASK >> 10) & 1) frac = (float)ts[70] / (float)ts[71];
            if ((PROBE_MASK >> 11) & 1) { unsigned long long w_ = 0ull, p_ = 0ull; for (int l = 0; l < DEPTH; ++l) { w_ += ts[1 + 8 * l + 3] - ts[80 + l]; p_ += ts[1 + 8 * l + 3] - ts[1 + 8 * l + 2]; } frac = (float)w_ / (float)p_; }
            dsh[0] = 0.5f * sqrtf(frac);
        }
        __syncthreads();
        asm volatile("s_waitcnt vmcnt(0)" ::: "memory");
        const float d = dsh[0];
        for (int i = otid(); i < 256 * 256; i += 512) a.out[(size_t)(i >> 8) * DM + (i & 255)] += d;
    }
#endif
}

extern "C" void kernel_launch(void* const* d_in, const int* in_sizes, int n_in, void* d_out, int out_size, void* d_ws, size_t ws_size, hipStream_t stream) {
    static int grid = 0;
    if (grid == 0) {
        if (n_in != 15 || out_size != T_TOK * DM || ws_size < WS_END) { fprintf(stderr, "kernel_launch: unexpected shapes (n_in %d out %d ws %zu need %zu)\n", n_in, out_size, ws_size, (size_t)WS_END); grid = -1; return; }
        int dev = 0, cus = 0, per_cu = 0;
        (void)hipGetDevice(&dev); (void)hipDeviceGetAttribute(&cus, hipDeviceAttributeMultiprocessorCount, dev);
        if (hipFuncSetAttribute((const void*)mega_fwd, hipFuncAttributeMaxDynamicSharedMemorySize, LDS_BYTES) != hipSuccess) { fprintf(stderr, "kernel_launch: hipFuncSetAttribute failed\n"); }
        if (hipOccupancyMaxActiveBlocksPerMultiprocessor(&per_cu, (const void*)mega_fwd, 512, LDS_BYTES) != hipSuccess || per_cu < 1) per_cu = 1;
        (void)hipGetLastError();
        grid = cus * (per_cu > 1 ? 1 : per_cu);
        if (grid <= 0) grid = 256;
    }
    if (grid < 0) return;
    Args a{};
    a.x = (const float*)d_in[0]; a.norm_mix = (const float*)d_in[1]; a.w_in = (const float*)d_in[2]; a.gate_bias = (const float*)d_in[3];
    a.conv_qk_w = (const float*)d_in[4]; a.conv_qk_b = (const float*)d_in[5]; a.mlstm_norm = (const float*)d_in[6]; a.qk_norm = (const float*)d_in[7];
    a.rel_bias = (const float*)d_in[8]; a.w_out = (const float*)d_in[9]; a.norm_ffn = (const float*)d_in[10]; a.w_up = (const float*)d_in[11];
    a.conv_ffn_w = (const float*)d_in[12]; a.conv_ffn_b = (const float*)d_in[13]; a.w_down = (const float*)d_in[14];
    a.out = (float*)d_out; a.ws = (unsigned char*)d_ws;
    (void)hipMemsetAsync((unsigned char*)d_ws + O_BAR, 0, 16384, stream);
    void* args[] = {&a};
    hipError_t e = hipLaunchCooperativeKernel((const void*)mega_fwd, dim3(grid), dim3(512), args, LDS_BYTES, stream);
    if (e != hipSuccess) fprintf(stderr, "kernel_launch: cooperative launch failed: %s (grid %d)\n", hipGetErrorString(e), grid);
}
```

```cpp
#include <hip/hip_runtime.h>
#include <hip/hip_cooperative_groups.h>
#include <cstdio>
#include <cmath>
namespace cg = cooperative_groups;
__device__ __forceinline__ int olane() { int l; asm volatile("v_mbcnt_lo_u32_b32 %0, -1, 0\n\tv_mbcnt_hi_u32_b32 %0, -1, %0" : "=v"(l)); return l; }
#define otid() ((a.wv << 6) | olane())
__device__ __forceinline__ float shx(float v, int m) { return __builtin_bit_cast(float, __builtin_amdgcn_ds_bpermute((olane() ^ m) << 2, __builtin_bit_cast(int, v))); }
__device__ __forceinline__ float shu(float v, int o) { const int l = olane(); return __builtin_bit_cast(float, __builtin_amdgcn_ds_bpermute((l >= o ? l - o : l) << 2, __builtin_bit_cast(int, v))); }
namespace pg8 {
#define PG8_LAS __attribute__((address_space(3)))
typedef unsigned short bf16_t;
typedef short bf16x8 __attribute__((ext_vector_type(8)));
typedef float f32x4 __attribute__((ext_vector_type(4)));
typedef unsigned u32x4 __attribute__((ext_vector_type(4)));
constexpr int BM = 256, BK = 64, HALF = 128, HTB = HALF * BK * 2  , STAGE_BYTES = 8 * HTB, NXCD = 8, WGM = 8;

__host__ __device__ __forceinline__ int lds_byte(int r, int c) { const int st = (r >> 4) * 2 + (c >> 5), rr = r & 15, cc = c & 31, ob = rr * 64 + cc * 2; return st * 1024 + (ob ^ (((ob >> 9) & 1) << 5)); }
__host__ __device__ __forceinline__ void stage_rc(int b, int& R, int& C) { const int st = b / 1024, sb = b % 1024, swz = sb ^ (((sb >> 9) & 1) << 5); R = (st >> 1) * 16 + swz / 64; C = (st & 1) * 32 + (swz % 64) / 2; }
__host__ __device__ __forceinline__ int perm32(int rho) { const int n = rho >> 4, i = rho & 15; return 8 * (i >> 2) + 4 * n + (i & 3); }

struct Unit { int pm, pn; };
struct Gemm { const bf16_t* A; const bf16_t* Bt; int M, N, K, wv; };

struct StaticOrder {
    int nM, nN, nwg, G, c;
    __host__ __device__ void init(int M, int N, int G_, int c_) { nM = M / BM; nN = N / BM; nwg = nM * nN; G = G_; c = c_; }
    __host__ __device__ bool next(int i, Unit& u) const {
        const long L = (long)i * G + c; if (L >= nwg) return false;
        int wgid = (int)L; { const int q = nwg / NXCD, r = nwg % NXCD, xcd = wgid % NXCD, off = wgid / NXCD; wgid = (xcd < r ? xcd * (q + 1) : r * (q + 1) + (xcd - r) * q) + off; }
        const int nig = WGM * nN, gid = wgid / nig, fm = gid * WGM, gsz = (nM - fm) < WGM ? (nM - fm) : WGM;
        u.pm = fm + ((wgid % nig) % gsz); u.pn = (wgid % nig) / gsz; return true;
    }
    __device__ __forceinline__ void a_ready(const Unit&) const {}
    __device__ __forceinline__ void done(const Unit&) const {}
};

__device__ __forceinline__ unsigned cvt_pk_bf16(float lo, float hi) { unsigned r; asm volatile("v_cvt_pk_bf16_f32 %0, %1, %2" : "=v"(r) : "v"(lo), "v"(hi)); return r; }

template <class Epi, class Sched, bool STAMP = false>
__device__ __forceinline__ void gemm_phase(PG8_LAS unsigned char* lds, const Gemm g, const Sched& S, const Epi& E, unsigned long long* stamps) {
    const int lane = olane(), wid = g.wv, tid = (wid << 6) | lane, wr = wid >> 2, wc = wid & 3, fr = lane & 15, fq = lane >> 4;
    const int K = g.K, nt = K / BK;
    int ts_lo = 0, ts_hi = 0, nts = 0; const unsigned long long rt_entry = STAMP ? (unsigned long long)wall_clock64() : 0ull;
#define PG8_STAMP() do { if (STAMP && wid == 0 && nts < 64) { const unsigned long long _c = (unsigned long long)clock64(); \
        ts_lo = (lane == nts) ? (int)(unsigned)_c : ts_lo; ts_hi = (lane == nts) ? (int)(unsigned)(_c >> 32) : ts_hi; ++nts; } } while (0)
    PG8_STAMP();
    unsigned voffA[2], voffB[2];
#pragma unroll
    for (int i = 0; i < 2; ++i) { int R, C; stage_rc(tid * 16 + i * 8192, R, C); const int Rb = Epi::PERM ? ((R & ~31) + perm32(R & 31)) : R;
        voffA[i] = (unsigned)(R * K + C) * 2u; voffB[i] = (unsigned)(Rb * K + C) * 2u; }
    const size_t kstep = (size_t)(BK * 2);
    const size_t hstep = (size_t)HALF * K * 2;
    const size_t tstep = 2 * hstep;
    const unsigned ldsw = (unsigned)wid * 1024u;
    const int aoff = lds_byte(wr * 64 + fr, fq * 8), boff = lds_byte(wc * 32 + fr, fq * 8);
#define PG8_SA(b, h) (((b) * 2 + (h)) * HTB)
#define PG8_SB(b, h) ((4 + (b) * 2 + (h)) * HTB)
#define PG8_STAGE(bufoff, gbase, voff) do { _Pragma("unroll") for (int _i = 0; _i < 2; ++_i) \
        __builtin_amdgcn_global_load_lds((const unsigned*)((const char*)(gbase) + (voff)[_i]), (PG8_LAS unsigned*)(lds + (bufoff) + ldsw + _i * 8192), 16, 0, 0); } while (0)
#define PG8_LDA(dst, b, h) do { _Pragma("unroll") for (int m = 0; m < 4; ++m) _Pragma("unroll") for (int k = 0; k < 2; ++k) dst[m][k] = *(const PG8_LAS bf16x8*)(lds + PG8_SA(b, h) + aoff + m * 2048 + k * 1024); } while (0)
#define PG8_LDB(dst, b, h) do { _Pragma("unroll") for (int n = 0; n < 2; ++n) _Pragma("unroll") for (int k = 0; k < 2; ++k) dst[n][k] = *(const PG8_LAS bf16x8*)(lds + PG8_SB(b, h) + boff + n * 2048 + k * 1024); } while (0)
#define PG8_MMA(ai, bj, At, Bt) do { __builtin_amdgcn_s_setprio(1); _Pragma("unroll") for (int m = 0; m < 4; ++m) _Pragma("unroll") for (int n = 0; n < 2; ++n) _Pragma("unroll") for (int k = 0; k < 2; ++k) \
        acc[ai][bj][m][n] = __builtin_amdgcn_mfma_f32_16x16x32_bf16(Bt[n][k], At[m][k], acc[ai][bj][m][n], 0, 0, 0); __builtin_amdgcn_s_setprio(0); } while (0)
#define PG8_WAIT_V(n) asm volatile("s_waitcnt vmcnt(" #n ")" ::: "memory")
#define PG8_WAIT_L(n) asm volatile("s_waitcnt lgkmcnt(" #n ")" ::: "memory")
#define PG8_BAR __builtin_amdgcn_s_barrier()
#define PG8_SCHED __builtin_amdgcn_sched_barrier(0)
    Unit cur, nxt; int ui = 0;
    if (!S.next(0, cur)) return;
    f32x4 acc[2][2][4][2];
#pragma unroll
    for (int a = 0; a < 2; ++a)
#pragma unroll
        for (int b = 0; b < 2; ++b)
#pragma unroll
            for (int m = 0; m < 4; ++m)
#pragma unroll
                for (int n = 0; n < 2; ++n) acc[a][b][m][n] = (f32x4){0.f, 0.f, 0.f, 0.f};
    bf16x8 At[4][2], B0[2][2], B1[2][2];
    const char* cA = (const char*)g.A + (size_t)cur.pm * tstep; const char* cB = (const char*)g.Bt + (size_t)cur.pn * tstep;
    S.a_ready(cur);
    PG8_STAGE(PG8_SB(0, 0), cB, voffB); PG8_STAGE(PG8_SA(0, 0), cA, voffA); PG8_STAGE(PG8_SB(0, 1), cB + hstep, voffB); PG8_STAGE(PG8_SA(0, 1), cA + hstep, voffA);
    if (wr == 1) PG8_BAR;
    PG8_WAIT_V(4); PG8_BAR;
    PG8_STAGE(PG8_SB(1, 0), cB + kstep, voffB); PG8_STAGE(PG8_SA(1, 0), cA + kstep, voffA); PG8_STAGE(PG8_SB(1, 1), cB + hstep + kstep, voffB);
    PG8_WAIT_V(6); PG8_BAR;
    PG8_STAMP();
    for (;;) {
        const bool has_next = S.next(ui + 1, nxt);
        const char* nA = has_next ? (const char*)g.A + (size_t)nxt.pm * tstep : cA; const char* nB = has_next ? (const char*)g.Bt + (size_t)nxt.pn * tstep : cB;
        for (int t = 0; t < nt; t += 2) {
            const bool last = (t == nt - 2);
            const char* a1 = cA + (size_t)(t + 1) * kstep;
            const char* a2 = last ? nA : cA + (size_t)(t + 2) * kstep; const char* b2 = last ? nB : cB + (size_t)(t + 2) * kstep;
            const char* a3 = a2 + kstep; const char* b3 = b2 + kstep;
            if (last && has_next) S.a_ready(nxt);
            PG8_LDB(B0, 0, 0); PG8_SCHED; PG8_LDA(At, 0, 0); PG8_STAGE(PG8_SA(1, 1), a1 + hstep, voffA);
            PG8_WAIT_L(8); PG8_BAR; PG8_WAIT_L(0); PG8_MMA(0, 0, At, B0); PG8_BAR; PG8_SCHED;
            PG8_LDB(B1, 0, 1); PG8_STAGE(PG8_SB(0, 0), b2, voffB);
            PG8_BAR; PG8_WAIT_L(0); PG8_MMA(0, 1, At, B1); PG8_BAR;
            PG8_LDA(At, 0, 1); PG8_STAGE(PG8_SA(0, 0), a2, voffA);
            PG8_BAR; PG8_WAIT_L(0); PG8_MMA(1, 0, At, B0); PG8_BAR; PG8_SCHED;
            PG8_STAGE(PG8_SB(0, 1), b2 + hstep, voffB);
            PG8_WAIT_V(6); PG8_BAR; PG8_MMA(1, 1, At, B1); PG8_BAR;
            PG8_LDB(B0, 1, 0); PG8_SCHED; PG8_LDA(At, 1, 0); PG8_STAGE(PG8_SA(0, 1), a2 + hstep, voffA);
            PG8_WAIT_L(8); PG8_BAR; PG8_WAIT_L(0); PG8_MMA(0, 0, At, B0); PG8_BAR; PG8_SCHED;
            PG8_LDB(B1, 1, 1); PG8_STAGE(PG8_SB(1, 0), b3, voffB);
            PG8_BAR; PG8_WAIT_L(0); PG8_MMA(0, 1, At, B1); PG8_BAR;
            PG8_LDA(At, 1, 1); PG8_STAGE(PG8_SA(1, 0), a3, voffA);
            PG8_BAR; PG8_WAIT_L(0); PG8_MMA(1, 0, At, B0); PG8_BAR; PG8_SCHED;
            PG8_STAGE(PG8_SB(1, 1), b3 + hstep, voffB);
            PG8_WAIT_V(6); PG8_BAR; PG8_MMA(1, 1, At, B1); PG8_BAR;
        }
        PG8_STAMP();
        if constexpr (!Epi::AFTER_DRAIN) { E(acc, cur, wr, wc, fr, fq); S.done(cur); }
        PG8_STAMP();
        if (!has_next) break;
#pragma unroll
        for (int a = 0; a < 2; ++a)
#pragma unroll
            for (int b = 0; b < 2; ++b)
#pragma unroll
                for (int m = 0; m < 4; ++m)
#pragma unroll
                    for (int n = 0; n < 2; ++n) acc[a][b][m][n] = (f32x4){0.f, 0.f, 0.f, 0.f};
        cur = nxt; cA = nA; cB = nB; ++ui;
    }
    PG8_WAIT_V(0);
    if (wr == 0) PG8_BAR;
    PG8_BAR;
    if constexpr (Epi::AFTER_DRAIN) { E.fused(acc, cur, wr, wc, fr, fq, lds, wid, lane); S.done(cur); }
    PG8_STAMP();
    if (STAMP && wid == 0) { stamps[lane] = lane < nts ? (((unsigned long long)(unsigned)ts_hi << 32) | (unsigned)ts_lo) : 0ull;
        if (lane == 62) stamps[62] = rt_entry; if (lane == 63) stamps[63] = (unsigned long long)wall_clock64(); }
#undef PG8_STAMP
#undef PG8_SA
#undef PG8_SB
#undef PG8_STAGE
#undef PG8_LDA
#undef PG8_LDB
#undef PG8_MMA
#undef PG8_WAIT_V
#undef PG8_WAIT_L
#undef PG8_BAR
#undef PG8_SCHED
}
}

using pg8::bf16_t; using pg8::bf16x8; using pg8::f32x4; using pg8::u32x4;
typedef unsigned u32x2 __attribute__((ext_vector_type(2)));
#define LAS __attribute__((address_space(3)))
#define DI __device__ __forceinline__
#define MFMA16(a, b, c) __builtin_amdgcn_mfma_f32_16x16x32_bf16((a), (b), (c), 0, 0, 0)

constexpr int T_TOK = 8192, DM = 2048, SEQ = 2048, DEPTH = 4;
constexpr int DIN_SRC = 7176, DINP = 7424, ZLD = 7168, DFF = 5632, DFF2 = 11264;
constexpr int LDS_BYTES = 147456;
constexpr float EPS = 1e-6f;

constexpr size_t al256(size_t x) { return (x + 255) & ~(size_t)255; }
constexpr size_t SZ_WIN = (size_t)DINP * DM * 2, SZ_WOUT = (size_t)DM * DM * 2, SZ_WUP = (size_t)DFF2 * DM * 2, SZ_WD = (size_t)DM * DFF * 2;
constexpr size_t O_WIN = 0;
constexpr size_t O_WOUT = O_WIN + 4 * SZ_WIN;
constexpr size_t O_WUP = O_WOUT + 4 * SZ_WOUT;
constexpr size_t O_WD = O_WUP + 4 * SZ_WUP;
constexpr size_t O_XB = O_WD + 4 * SZ_WD;
constexpr size_t O_Z = O_XB + (size_t)T_TOK * DM * 2;
constexpr size_t O_GATES = O_Z + (size_t)T_TOK * ZLD * 2;
constexpr size_t O_QC = O_GATES + (size_t)T_TOK * 8 * 4;
constexpr size_t O_KC = O_QC + (size_t)T_TOK * 1024 * 2;
constexpr size_t O_KT = O_KC + (size_t)T_TOK * 1024 * 2;
constexpr size_t O_VT = O_KT + (size_t)T_TOK * 1024 * 2;
constexpr size_t O_GSC = O_VT + (size_t)T_TOK * 1024 * 2;
constexpr size_t O_ACH = O_GSC + (size_t)5 * 16 * 2048 * 4;
constexpr size_t O_AQN = O_ACH + 4096;
constexpr size_t O_AKN = O_AQN + (size_t)T_TOK * 1024 * 2;
constexpr size_t O_AVT = O_AKN + (size_t)T_TOK * 1024 * 2;
constexpr size_t O_KMEAN = O_AVT + (size_t)T_TOK * 1024 * 2;
constexpr size_t O_HBUF = O_KMEAN + (size_t)32 * 8 * 128 * 4;
constexpr size_t O_HSS = O_HBUF + (size_t)T_TOK * 1024 * 4;
constexpr size_t O_MIX = O_HSS + (size_t)T_TOK * 4 * 8;
constexpr size_t O_U = O_MIX + (size_t)T_TOK * DM * 2;
constexpr size_t O_ACT = O_U + (size_t)T_TOK * DFF2 * 2;
constexpr size_t O_SS = O_ACT + (size_t)T_TOK * DFF * 2;
constexpr size_t O_BIAST = O_SS + (size_t)9 * T_TOK * 8;
constexpr size_t O_TS = O_BIAST + (size_t)8 * 2048 * 4;
constexpr size_t O_CS = O_TS + 4096;
constexpr size_t O_NS = O_CS + (size_t)256 * 32 * 4096 * 2;
constexpr size_t O_BAR = O_NS + (size_t)16 * 32 * 256 * 4;
constexpr size_t WS_END = O_BAR + 16384;

struct Args {
    const float* x; const float* norm_mix; const float* w_in; const float* gate_bias; const float* conv_qk_w; const float* conv_qk_b;
    const float* mlstm_norm; const float* qk_norm; const float* rel_bias; const float* w_out; const float* norm_ffn; const float* w_up;
    const float* conv_ffn_w; const float* conv_ffn_b; const float* w_down;
    float* out; unsigned char* ws;
    int wv; int pad_;
};

DI unsigned f2bf(float f) { unsigned u = __builtin_bit_cast(unsigned, f); return (u + 0x7fffu + ((u >> 16) & 1u)) >> 16; }
typedef __bf16 bf16v2_t __attribute__((ext_vector_type(2)));
typedef float f32x2_t __attribute__((ext_vector_type(2)));
DI unsigned pk2(float lo, float hi) { f32x2_t v = {lo, hi}; return __builtin_bit_cast(unsigned, __builtin_convertvector(v, bf16v2_t)); }
DI float bflo(unsigned w) { return __builtin_bit_cast(float, w << 16); }
DI float bfhi(unsigned w) { return __builtin_bit_cast(float, w & 0xffff0000u); }
DI float bf1(bf16_t b) { return __builtin_bit_cast(float, ((unsigned)b) << 16); }
DI void unpack8(const u32x4 v, float (&f)[8]) { f[0] = bflo(v.x); f[1] = bfhi(v.x); f[2] = bflo(v.y); f[3] = bfhi(v.y); f[4] = bflo(v.z); f[5] = bfhi(v.z); f[6] = bflo(v.w); f[7] = bfhi(v.w); }
DI u32x4 pack8(const float (&f)[8]) { u32x4 r; r.x = pk2(f[0], f[1]); r.y = pk2(f[2], f[3]); r.z = pk2(f[4], f[5]); r.w = pk2(f[6], f[7]); return r; }
typedef unsigned long long u64;
constexpr float SS_SCALE = 268435456.0f, SS_INV = 1.0f / 268435456.0f;
constexpr float HS_SCALE = 4294967296.0f, HS_INV = 1.0f / 4294967296.0f;
DI u64 to_fix(float v, float scale) { return (u64)(v * scale + 0.5f); }
DI void bar_lds() { asm volatile("s_waitcnt lgkmcnt(0)" ::: "memory"); __builtin_amdgcn_s_barrier(); asm volatile("" ::: "memory"); }
DI float sigmoidf_(float x) { return __builtin_amdgcn_rcpf(1.0f + __builtin_amdgcn_exp2f(x * -1.4426950408889634f)); }
DI float siluf_(float x) { return x * __builtin_amdgcn_rcpf(1.0f + __builtin_amdgcn_exp2f(x * -1.4426950408889634f)); }

struct EpiScale {
    static constexpr bool PERM = true, AFTER_DRAIN = false;
    bf16_t* O; int ldc; const u64* SS; float* gates; int gate_pn;
    DI void operator()(const f32x4 (&acc)[2][2][4][2], const pg8::Unit& u, int wr, int wc, int fr, int fq) const {
        const int row0 = u.pm * 256 + wr * 64 + fr, col0 = u.pn * 256 + wc * 32 + 8 * fq;
#pragma unroll
        for (int ai = 0; ai < 2; ++ai)
#pragma unroll
            for (int m = 0; m < 4; ++m) {
                const int r = row0 + ai * 128 + m * 16;
                const float rstd = rsqrtf((float)SS[r] * (SS_INV / 2048.0f) + EPS);
                if (u.pn == gate_pn) {
                    if (wc == 0 && fq == 0) { *(f32x4*)(gates + (size_t)r * 8) = acc[ai][0][m][0] * rstd; *(f32x4*)(gates + (size_t)r * 8 + 4) = acc[ai][0][m][1] * rstd; }
                } else {
                    bf16_t* rowp = O + (size_t)r * ldc + col0;
#pragma unroll
                    for (int bj = 0; bj < 2; ++bj) { const f32x4 v0 = acc[ai][bj][m][0] * rstd, v1 = acc[ai][bj][m][1] * rstd;
                        u32x4 w; w.x = pk2(v0[0], v0[1]); w.y = pk2(v0[2], v0[3]); w.z = pk2(v1[0], v1[1]); w.w = pk2(v1[2], v1[3]);
                        *(u32x4*)(rowp + bj * 128) = w; }
                }
            }
    }
};
struct EpiRes {
    static constexpr bool PERM = false, AFTER_DRAIN = false;
    float* X; bf16_t* XB; u64* SS;
    DI void operator()(const f32x4 (&acc)[2][2][4][2], const pg8::Unit& u, int wr, int wc, int fr, int fq) const {
        const int row0 = u.pm * 256 + wr * 64 + fr, col0 = u.pn * 256 + wc * 32 + 4 * fq;
#pragma unroll
        for (int ai = 0; ai < 2; ++ai)
#pragma unroll
            for (int m = 0; m < 4; ++m) {
                const int r = row0 + ai * 128 + m * 16;
                bf16_t* bp = XB + (size_t)r * DM + col0; float ssq = 0.f;
                u32x2 old[2][2];
#pragma unroll
                for (int bj = 0; bj < 2; ++bj)
#pragma unroll
                    for (int n = 0; n < 2; ++n) old[bj][n] = *(const u32x2*)(bp + bj * 128 + n * 16);
#pragma unroll
                for (int bj = 0; bj < 2; ++bj)
#pragma unroll
                    for (int n = 0; n < 2; ++n) { f32x4 v = acc[ai][bj][m][n];
                        v[0] += bflo(old[bj][n].x); v[1] += bfhi(old[bj][n].x); v[2] += bflo(old[bj][n].y); v[3] += bfhi(old[bj][n].y);
                        ssq += v[0] * v[0] + v[1] * v[1] + v[2] * v[2] + v[3] * v[3];
                        u32x2 p; p.x = pk2(v[0], v[1]); p.y = pk2(v[2], v[3]); *(u32x2*)(bp + bj * 128 + n * 16) = p;
                        if (X) __builtin_nontemporal_store(v, (f32x4*)(X + (size_t)r * DM + col0 + bj * 128 + n * 16)); }
                ssq += shx(ssq, 16); ssq += shx(ssq, 32);
                if (fq == 0) atomicAdd(SS + r, to_fix(ssq, SS_SCALE));
            }
    }
};

template <class Epi> DI void run_gemm(unsigned char* smem, const bf16_t* A, const bf16_t* Bt, int M, int N, int K, const Epi& E, int wv) {
    pg8::Gemm g; g.A = A; g.Bt = Bt; g.M = M; g.N = N; g.K = K; g.wv = wv;
    pg8::StaticOrder S; S.init(M, N, (int)gridDim.x, (int)blockIdx.x);
    pg8::gemm_phase<Epi, pg8::StaticOrder, false>((PG8_LAS unsigned char*)smem, g, S, E, nullptr);
}

struct TG { const float* src; const float* g; bf16_t* dst; int ldsrc, sc, nv, k0, ldd, n0; };
DI TG decode_tg(const Args& a, int it) {
    constexpr int PER_LAYER = 29 * 32 + 8 * 32 + 44 * 32 + 8 * 88;
    const int l = it / PER_LAYER; int r = it % PER_LAYER; TG t;
    if (r < 29 * 32) { const int kt = r / 29, gi = r % 29;
        if (gi < 16) { t.sc = gi * 256; t.nv = 256; } else if (gi < 28) { t.sc = gi * 256 + 8; t.nv = 256; } else { t.sc = 4096; t.nv = 8; }
        t.src = a.w_in + (size_t)l * DM * DIN_SRC; t.ldsrc = DIN_SRC; t.k0 = kt * 64; t.g = a.norm_mix + l * DM; t.dst = (bf16_t*)(a.ws + O_WIN + l * SZ_WIN); t.ldd = DM; t.n0 = gi * 256;
    } else if ((r -= 29 * 32) < 8 * 32) { const int kt = r / 8, gi = r % 8;
        t.src = a.w_out + (size_t)l * DM * DM; t.ldsrc = DM; t.sc = gi * 256; t.nv = 256; t.k0 = kt * 64; t.g = nullptr; t.dst = (bf16_t*)(a.ws + O_WOUT + l * SZ_WOUT); t.ldd = DM; t.n0 = gi * 256;
    } else if ((r -= 8 * 32) < 44 * 32) { const int kt = r / 44, gi = r % 44;
        t.src = a.w_up + (size_t)l * DM * DFF2; t.ldsrc = DFF2; t.sc = gi * 256; t.nv = 256; t.k0 = kt * 64; t.g = a.norm_ffn + l * DM; t.dst = (bf16_t*)(a.ws + O_WUP + l * SZ_WUP); t.ldd = DM; t.n0 = gi * 256;
    } else { r -= 44 * 32; const int kt = r / 8, gi = r % 8;
        t.src = a.w_down + (size_t)l * DFF * DM; t.ldsrc = DM; t.sc = gi * 256; t.nv = 256; t.k0 = kt * 64; t.g = nullptr; t.dst = (bf16_t*)(a.ws + O_WD + l * SZ_WD); t.ldd = DFF; t.n0 = gi * 256; }
    return t;
}
DI void tg_load(const TG& t, int tid, f32x4 (&v)[8], float (&gv)[8]) {
    const int c4 = (tid & 63) * 4, kr = tid >> 6;
#pragma unroll
    for (int i = 0; i < 8; ++i) { v[i] = (f32x4){0.f, 0.f, 0.f, 0.f}; if (c4 < t.nv) v[i] = __builtin_nontemporal_load((const f32x4*)(t.src + (size_t)(t.k0 + kr + 8 * i) * t.ldsrc + t.sc + c4));
        gv[i] = t.g ? t.g[t.k0 + kr + 8 * i] : 1.0f; }
}

DI int t5_bucket(int d) {
    if (d < 16) return d;
    const float ratio = (float)d / 16.0f;
    int large = 16 + (int)(logf(ratio) / 4.852030263919617f * 16.0f);
    return large < 31 ? large : 31;
}

DI void phase0(const Args& a, unsigned char* smem) {
    float* tile = (float*)smem;
    const int tid = otid();
    constexpr int PER_LAYER = 29 * 32 + 8 * 32 + 44 * 32 + 8 * 88;
    constexpr int NTILES = 4 * PER_LAYER, NX = 1024;
    {
        f32x4 v[8]; float gv[8]; TG cur, nx;
        int it = blockIdx.x;
        if (it < NTILES) { cur = decode_tg(a, NTILES - 1 - it); tg_load(cur, tid, v, gv); }
#pragma unroll 1
        for (; it < NTILES; it += gridDim.x) {
            { const int c4 = (tid & 63) * 4, kr = tid >> 6;
#pragma unroll
              for (int i = 0; i < 8; ++i) { const f32x4 vv = v[i] * gv[i]; float* tp = tile + (kr + 8 * i) * 260 + c4; *(f32x4*)tp = vv; } }
            const int nxt = it + gridDim.x;
            nx = cur;
            if (nxt < NTILES) { nx = decode_tg(a, NTILES - 1 - nxt); tg_load(nx, tid, v, gv); }
            bar_lds();
            { const int n = tid >> 1, kh = (tid & 1) * 32; const bool late = (NTILES - 1 - it) >= 2 * PER_LAYER;
#pragma unroll
              for (int q = 0; q < 4; ++q) { float f[8];
#pragma unroll
                  for (int j = 0; j < 8; ++j) f[j] = tile[(kh + q * 8 + j) * 260 + n];
                  u32x4* dp = (u32x4*)(cur.dst + (size_t)(cur.n0 + n) * cur.ldd + cur.k0 + kh + q * 8);
                  if (late) __builtin_nontemporal_store(pack8(f), dp); else *dp = pack8(f); } }
            bar_lds();
            cur = nx;
        }
    }
    for (int it = blockIdx.x; it < NX; it += gridDim.x) {
        {
            const int row = it * 8 + (tid >> 6), lane = tid & 63;
            const float* xp = a.x + (size_t)row * DM; bf16_t* bp = (bf16_t*)(a.ws + O_XB) + (size_t)row * DM;
            float ssq = 0.f;
#pragma unroll
            for (int i = 0; i < 8; ++i) { const int c = (i * 64 + lane) * 4; const f32x4 v = *(const f32x4*)(xp + c);
                ssq += v[0] * v[0] + v[1] * v[1] + v[2] * v[2] + v[3] * v[3]; u32x2 p; p.x = pk2(v[0], v[1]); p.y = pk2(v[2], v[3]); *(u32x2*)(bp + c) = p; }
#pragma unroll
            for (int o = 1; o < 64; o <<= 1) ssq += shx(ssq, o);
            if (lane == 0) ((u64*)(a.ws + O_SS))[row] = to_fix(ssq, SS_SCALE);
        }
    }
    const int gt = blockIdx.x * 512 + tid, gn = gridDim.x * 512;
    u64* ss = (u64*)(a.ws + O_SS);
    { const u64 z0 = (u64)((unsigned)tid >> 31); for (int i = gt; i < 8 * T_TOK; i += gn) ss[T_TOK + i] = z0; }
    float* bt = (float*)(a.ws + O_BIAST);
    for (int i = gt; i < 8 * 2048; i += gn) { const int h = i >> 11, d = i & 2047; bt[i] = a.rel_bias[t5_bucket(d) * 8 + h] * 1.4426950408889634f; }
}

DI void prep_mlstm_item(const Args& a, int l, int item, unsigned char* smem) {
    const int bh = item >> 5, c = item & 31, b = bh >> 2, h = bh & 3, tid = otid();
    const bf16_t* z = (const bf16_t*)(a.ws + O_Z);
    bf16_t* tileK = (bf16_t*)smem; bf16_t* tileV = (bf16_t*)(smem + 64 * 264 * 2);
    const int cg8 = tid & 31, rg = tid >> 5;
    const size_t trow0 = (size_t)b * SEQ + c * 64;
    u32x4 zr[2][7], vr[4]; f32x4 wv[2][4][2], bv[2][2];
#pragma unroll
    for (int part = 0; part < 2; ++part) { const int ch0 = part * 1024 + h * 256 + cg8 * 8;
#pragma unroll
        for (int i = 0; i < 7; ++i) { const int sl = c * 64 + rg * 4 - 3 + i; zr[part][i] = (u32x4){0u, 0u, 0u, 0u}; if (sl >= 0) zr[part][i] = __builtin_nontemporal_load((const u32x4*)(z + ((size_t)b * SEQ + sl) * ZLD + ch0)); } }
    { const int row = tid >> 3, seg = tid & 7;
#pragma unroll
      for (int i = 0; i < 4; ++i) vr[i] = __builtin_nontemporal_load((const u32x4*)(z + (trow0 + row) * ZLD + 2048 + h * 256 + seg * 8 + i * 64)); }
#pragma unroll
    for (int part = 0; part < 2; ++part) { const int ch0 = part * 1024 + h * 256 + cg8 * 8;
        const float* cw = a.conv_qk_w + (size_t)l * 4 * 2048 + ch0; const float* cb = a.conv_qk_b + (size_t)l * 2048 + ch0;
#pragma unroll
        for (int j = 0; j < 4; ++j) { wv[part][j][0] = *(const f32x4*)(cw + j * 2048); wv[part][j][1] = *(const f32x4*)(cw + j * 2048 + 4); }
        bv[part][0] = *(const f32x4*)cb; bv[part][1] = *(const f32x4*)(cb + 4); }
    __syncthreads();
    { const int row = tid >> 3, seg = tid & 7;
#pragma unroll
      for (int i = 0; i < 4; ++i) *(u32x4*)(tileV + row * 264 + seg * 8 + i * 64) = vr[i]; }
#pragma unroll
    for (int part = 0; part < 2; ++part) {
        float xin[7][8];
#pragma unroll
        for (int i = 0; i < 7; ++i) unpack8(zr[part][i], xin[i]);
        bf16_t* dst = (bf16_t*)(a.ws + (part == 0 ? O_QC : O_KC));
        const float osc = part == 0 ? 0.0625f : 1.0f;
#pragma unroll
        for (int o = 0; o < 4; ++o) { float y[8];
#pragma unroll
            for (int e = 0; e < 8; ++e) { float s_ = bv[part][e >> 2][e & 3];
#pragma unroll
                for (int j = 0; j < 4; ++j) s_ += wv[part][j][e >> 2][e & 3] * xin[o + j][e];
                y[e] = siluf_(s_) * osc; }
            const u32x4 pk = pack8(y);
            *(u32x4*)(dst + (trow0 + rg * 4 + o) * 1024 + h * 256 + cg8 * 8) = pk;
            if (part == 1) *(u32x4*)(tileK + (rg * 4 + o) * 264 + cg8 * 8) = pk; }
    }
    bar_lds();
    { const int d = tid >> 1, sh = tid & 1;
      bf16_t* kT = (bf16_t*)(a.ws + O_KT) + ((size_t)(bh * 32 + c) * 256 + d) * 64 + sh * 32;
      bf16_t* vT = (bf16_t*)(a.ws + O_VT) + ((size_t)(bh * 32 + c) * 256 + d) * 64 + sh * 32;
#pragma unroll
      for (int i = 0; i < 4; ++i) { unsigned w1[4], w2[4];
#pragma unroll
          for (int j = 0; j < 4; ++j) { const int s_ = sh * 32 + i * 8 + j * 2;
              w1[j] = (unsigned)tileK[s_ * 264 + d] | ((unsigned)tileK[(s_ + 1) * 264 + d] << 16);
              w2[j] = (unsigned)tileV[s_ * 264 + d] | ((unsigned)tileV[(s_ + 1) * 264 + d] << 16); }
          u32x4 v1, v2; v1.x = w1[0]; v1.y = w1[1]; v1.z = w1[2]; v1.w = w1[3]; v2.x = w2[0]; v2.y = w2[1]; v2.z = w2[2]; v2.w = w2[3];
          *(u32x4*)(kT + i * 8) = v1; *(u32x4*)(vT + i * 8) = v2; } }
    bar_lds();
}

DI void prep_attn_item(const Args& a, int l, int item, unsigned char* smem) {
    const int b = item >> 6, blk = (item >> 3) & 7, head = item & 7, tid = otid();
    const bf16_t* z = (const bf16_t*)(a.ws + O_Z);
    bf16_t* tile = (bf16_t*)smem;
    float* part = (float*)(smem + 256 * 136 * 2);
    const int lr = tid >> 4, cgp = tid & 15;
    const size_t t0 = (size_t)b * SEQ + blk * 256;
    float g0[8], g1[8], colsum[8];
    { const float* gp = a.qk_norm + (size_t)l * 256 + cgp * 8;
#pragma unroll
      for (int e = 0; e < 8; ++e) { g0[e] = gp[e] * (0.08838834764831845f * 1.4426950408889634f); g1[e] = gp[128 + e]; colsum[e] = 0.f; } }
    bf16_t* aqn = (bf16_t*)(a.ws + O_AQN); bf16_t* akn = (bf16_t*)(a.ws + O_AKN);
#pragma unroll 1
    for (int pb = 0; pb < 2; ++pb) {
        u32x4 rq[4], rk[4], rv[4];
#pragma unroll
        for (int pp = 0; pp < 4; ++pp) { const int r = (pb * 4 + pp) * 32 + lr; const bf16_t* zr = z + (t0 + r) * ZLD + head * 128 + cgp * 8;
            rq[pp] = __builtin_nontemporal_load((const u32x4*)(zr + 4096)); rk[pp] = __builtin_nontemporal_load((const u32x4*)(zr + 5120)); rv[pp] = __builtin_nontemporal_load((const u32x4*)(zr + 6144)); }
#pragma unroll
        for (int pp = 0; pp < 4; ++pp) { const int r = (pb * 4 + pp) * 32 + lr;
            float f[8], y[8];
            { unpack8(rq[pp], f); float ssq = 0.f;
#pragma unroll
              for (int e = 0; e < 8; ++e) ssq += f[e] * f[e];
              ssq += shx(ssq, 1); ssq += shx(ssq, 2); ssq += shx(ssq, 4); ssq += shx(ssq, 8);
              const float rstd = rsqrtf(ssq * (1.0f / 128.0f) + EPS);
#pragma unroll
              for (int e = 0; e < 8; ++e) y[e] = f[e] * rstd * g0[e];
              *(u32x4*)(aqn + (t0 + r) * 1024 + head * 128 + cgp * 8) = pack8(y); }
            { unpack8(rk[pp], f); float ssq = 0.f;
#pragma unroll
              for (int e = 0; e < 8; ++e) ssq += f[e] * f[e];
              ssq += shx(ssq, 1); ssq += shx(ssq, 2); ssq += shx(ssq, 4); ssq += shx(ssq, 8);
              const float rstd = rsqrtf(ssq * (1.0f / 128.0f) + EPS);
#pragma unroll
              for (int e = 0; e < 8; ++e) { y[e] = f[e] * rstd * g1[e]; colsum[e] += y[e]; }
              *(u32x4*)(akn + (t0 + r) * 1024 + head * 128 + cgp * 8) = pack8(y); }
            *(u32x4*)(tile + r * 136 + cgp * 8) = rv[pp]; }
    }
#pragma unroll
    for (int e = 0; e < 8; ++e) part[lr * 128 + cgp * 8 + e] = colsum[e];
    __syncthreads();
    if (tid < 128) { float s = 0.f;
#pragma unroll 8
        for (int i = 0; i < 32; ++i) s += part[i * 128 + tid];
        ((float*)(a.ws + O_KMEAN))[((size_t)(b * 8 + head) * 8 + blk) * 128 + tid] = s * (1.0f / 256.0f); }
    { const int d = tid >> 2, seg = tid & 3; bf16_t* vT = (bf16_t*)(a.ws + O_AVT) + ((size_t)(b * 8 + head) * 128 + d) * SEQ + blk * 256 + seg * 64;
#pragma unroll
      for (int i = 0; i < 8; ++i) { unsigned wv[4];
#pragma unroll
          for (int j = 0; j < 4; ++j) { const int r = seg * 64 + i * 8 + j * 2; wv[j] = (unsigned)tile[r * 136 + d] | ((unsigned)tile[(r + 1) * 136 + d] << 16); }
          u32x4 v; v.x = wv[0]; v.y = wv[1]; v.z = wv[2]; v.w = wv[3]; *(u32x4*)(vT + i * 8) = v; } }
    __syncthreads();
}

DI void prep_gate_item(const Args& a, int l, int bh, unsigned char* smem) {
    const int tid = otid(), w = tid >> 6, lane = tid & 63, b = bh >> 2, h = bh & 3;
    float* gl = (float*)smem;
    const float* gates = (const float*)(a.ws + O_GATES); float* gsc = (float*)(a.ws + O_GSC); float* ach = (float*)(a.ws + O_ACH);
    const float bi = a.gate_bias[l * 8 + h], bf = a.gate_bias[l * 8 + 4 + h];
    float u_[4], bs_[4], cm_[4];
#pragma unroll
    for (int i = 0; i < 4; ++i) { const int c = w * 4 + i; const size_t t = (size_t)b * SEQ + c * 64 + lane;
        const float li = gates[t * 8 + h] + bi, xf = gates[t * 8 + 4 + h] + bf;
        const float lf = fminf(xf, 0.f) - log1pf(expf(-fabsf(xf)));
        float bs = lf;
#pragma unroll
        for (int o = 1; o < 64; o <<= 1) { const float v = shu(bs, o); if (lane >= o) bs += v; }
        const float u = li - bs; float cm = u;
#pragma unroll
        for (int o = 1; o < 64; o <<= 1) { const float v = shu(cm, o); if (lane >= o) cm = fmaxf(cm, v); }
        u_[i] = u; bs_[i] = bs; cm_[i] = cm;
        if (lane == 63) { gl[c] = bs; gl[32 + c] = cm; } }
    __syncthreads();
    if (tid == 0) { float m = 0.f;
#pragma unroll 1
        for (int c = 0; c < 32; ++c) { gl[64 + c] = m; m = gl[c] + fmaxf(m, gl[32 + c]); } }
    __syncthreads();
#pragma unroll
    for (int i = 0; i < 4; ++i) { const int c = w * 4 + i; const float m = gl[64 + c];
        const float M = fmaxf(m, cm_[i]), W = expf(m - M), F = expf(-(bs_[i] + M)), M63 = fmaxf(m, gl[32 + c]);
        const size_t o = (size_t)bh * SEQ + c * 64 + lane;
        gsc[o] = u_[i]; gsc[32768 + o] = M; gsc[65536 + o] = W; gsc[98304 + o] = F; gsc[131072 + o] = expf(u_[i] - M63);
        if (lane == 0) ach[bh * 32 + c] = expf(m - M63); }
    __syncthreads();
}

DI void phase_prep(const Args& a, int l, unsigned char* smem) {
    for (int it = blockIdx.x; it < 512 + 256 + 16; it += gridDim.x) {
        if (it < 512) { const int i = it & 255, xcd = i & 7, slot = i >> 3, bh = xcd * 2 + (slot >> 4), c = (slot & 15) + 16 * (it >> 8); prep_mlstm_item(a, l, bh * 32 + c, smem); }
        else if (it < 768) { const int i = it - 512, xcd = i & 7, slot = i >> 3, bh = xcd * 4 + (slot >> 3), blk = slot & 7; prep_attn_item(a, l, (bh >> 3) * 64 + blk * 8 + (bh & 7), smem); }
        else { const int i = it - 768; prep_gate_item(a, l, (i & 7) * 2 + (i >> 3), smem); }
    }
}

DI void mlstm_item(const Args& a, int item, unsigned char* smem) {
    const int bh = item >> 4, es = item & 15, b = bh >> 2, h = bh & 3, e0 = es * 16;
    const int tid = otid(), w = tid >> 6, lane = tid & 63, fr = lane & 15, fq = lane >> 4;
    float* nst = (float*)smem;
    float* gU = (float*)(smem + 32768); float* gM = gU + 2048; float* gW = gM + 2048; float* gF = gW + 2048; float* gWK = gF + 2048; float* adecs = gWK + 2048;
    const bf16_t* qc = (const bf16_t*)(a.ws + O_QC); const bf16_t* kc = (const bf16_t*)(a.ws + O_KC);
    const bf16_t* kT = (const bf16_t*)(a.ws + O_KT); const bf16_t* vT = (const bf16_t*)(a.ws + O_VT);
    const float* gsc = (const float*)(a.ws + O_GSC); const float* ach = (const float*)(a.ws + O_ACH);
    float* NS = (float*)(a.ws + O_NS);
    bf16_t* CS = (bf16_t*)(a.ws + O_CS) + (size_t)item * 32 * 4096;
    __syncthreads();
    for (int i = tid; i < 2048; i += 512) { const size_t o = (size_t)bh * SEQ + i; gWK[i] = gsc[131072 + o]; }
    if (tid < 32) adecs[tid] = ach[bh * 32 + tid];
    __syncthreads();
    {
        f32x4 accC[2]; accC[0] = (f32x4){0.f, 0.f, 0.f, 0.f}; accC[1] = accC[0]; float nacc[2] = {0.f, 0.f};
        const bf16_t* ktp = kT + ((size_t)(bh * 32) * 256 + (2 * w) * 16 + fr) * 64 + fq * 8;
        const bf16_t* vtp = vT + ((size_t)(bh * 32) * 256 + e0 + fr) * 64 + fq * 8;
        bf16x8 rk[4][4], rv[4][2];
#define LA_LOAD(set, cc) do { _Pragma("unroll") for (int i_ = 0; i_ < 2; ++i_) _Pragma("unroll") for (int k_ = 0; k_ < 2; ++k_) rk[set][i_ * 2 + k_] = *(const bf16x8*)(ktp + (size_t)(cc) * 16384 + i_ * 1024 + k_ * 32); \
        _Pragma("unroll") for (int k_ = 0; k_ < 2; ++k_) rv[set][k_] = *(const bf16x8*)(vtp + (size_t)(cc) * 16384 + k_ * 32); } while (0)
        LA_LOAD(0, 0); LA_LOAD(1, 1); LA_LOAD(2, 2); LA_LOAD(3, 3);
#pragma unroll
        for (int c0 = 0; c0 < 32; c0 += 4) {
#pragma unroll
            for (int j = 0; j < 4; ++j) { const int c = c0 + j;
                if (c < 31) {
                    const float adec = adecs[c];
                    bf16x8 vw[2]; float wk[2][8];
#pragma unroll
                    for (int kk = 0; kk < 2; ++kk) { const f32x4 w0 = *(const f32x4*)(gWK + c * 64 + kk * 32 + fq * 8), w1 = *(const f32x4*)(gWK + c * 64 + kk * 32 + fq * 8 + 4);
                        wk[kk][0] = w0[0]; wk[kk][1] = w0[1]; wk[kk][2] = w0[2]; wk[kk][3] = w0[3]; wk[kk][4] = w1[0]; wk[kk][5] = w1[1]; wk[kk][6] = w1[2]; wk[kk][7] = w1[3];
                        float f[8]; unpack8(__builtin_bit_cast(u32x4, rv[j][kk]), f);
#pragma unroll
                        for (int e = 0; e < 8; ++e) f[e] *= wk[kk][e];
                        vw[kk] = __builtin_bit_cast(bf16x8, pack8(f)); }
#pragma unroll
                    for (int i = 0; i < 2; ++i) { f32x4 acc = accC[i] * adec;
#pragma unroll
                        for (int kk = 0; kk < 2; ++kk) acc = MFMA16(rk[j][i * 2 + kk], vw[kk], acc);
                        accC[i] = acc;
                        u32x2 pw; pw.x = pk2(acc[0], acc[1]); pw.y = pk2(acc[2], acc[3]);
                        *(u32x2*)(CS + (size_t)(c + 1) * 4096 + fr * 256 + (2 * w + i) * 16 + 4 * fq) = pw;
                        if (2 * w + i == es) {
                            float ns = 0.f;
#pragma unroll
                            for (int kk = 0; kk < 2; ++kk) { float f[8]; unpack8(__builtin_bit_cast(u32x4, rk[j][i * 2 + kk]), f);
#pragma unroll
                                for (int e = 0; e < 8; ++e) ns += f[e] * wk[kk][e]; }
                            ns += shx(ns, 16); ns += shx(ns, 32); nacc[i] = adec * nacc[i] + ns;
                            if (fq == 0) NS[(size_t)(bh * 32 + c + 1) * 256 + (2 * w + i) * 16 + fr] = nacc[i]; } }
                }
                if (c + 4 < 31) LA_LOAD(j, c + 4);
            }
        }
#undef LA_LOAD
    }
}

constexpr int MO_QS = 0, MO_KS = 34816, MO_PS = 69632, MO_RSP = 79872, MO_QN = 80896, MO_HSQ = 81152, MO_NL = 83200, MO_SCL = 84224;
DI void mlstm_out_item(const Args& a, int l, int item, unsigned char* smem) {
    const int bh = item >> 5, c = item & 31, b = bh >> 2, h = bh & 3;
    const int tid = otid(), w = tid >> 6, lane = tid & 63, fr = lane & 15, fq = lane >> 4;
    bf16_t* Qs = (bf16_t*)(smem + MO_QS); bf16_t* Ks = (bf16_t*)(smem + MO_KS); bf16_t* Ps = (bf16_t*)(smem + MO_PS);
    float* rsp = (float*)(smem + MO_RSP); float* qnv = (float*)(smem + MO_QN); float* hsq = (float*)(smem + MO_HSQ); float* nloc = (float*)(smem + MO_NL); float* scl = (float*)(smem + MO_SCL);
    const bf16_t* qc = (const bf16_t*)(a.ws + O_QC); const bf16_t* kc = (const bf16_t*)(a.ws + O_KC); const bf16_t* vT = (const bf16_t*)(a.ws + O_VT);
    const float* gsc = (const float*)(a.ws + O_GSC); const bf16_t* CS = (const bf16_t*)(a.ws + O_CS); const float* NS = (const float*)(a.ws + O_NS);
    const size_t tb = (size_t)b * SEQ + c * 64;
    __syncthreads();
    { const int qrow = tid >> 3, qseg = tid & 7; u32x4 pq[4], pk[4];
#pragma unroll
      for (int i = 0; i < 4; ++i) { pq[i] = *(const u32x4*)(qc + (tb + qrow) * 1024 + h * 256 + (qseg + 8 * i) * 8); pk[i] = *(const u32x4*)(kc + (tb + qrow) * 1024 + h * 256 + (qseg + 8 * i) * 8); }
      { const unsigned z0 = (unsigned)tid >> 31; u32x4 zz; zz.x = z0; zz.y = z0; zz.z = z0; zz.w = z0;
        for (int i = tid; i < 640; i += 512) ((u32x4*)Ps)[i] = zz; }
      if (tid < 256) nloc[tid] = (c > 0) ? NS[(size_t)(bh * 32 + c) * 256 + tid] : 0.f;
      else scl[tid - 256] = gsc[(size_t)((tid - 256) >> 6) * 32768 + (size_t)bh * SEQ + c * 64 + (tid & 63)];
#pragma unroll
      for (int i = 0; i < 4; ++i) { *(u32x4*)(Qs + qrow * 272 + (qseg + 8 * i) * 8) = pq[i]; *(u32x4*)(Ks + qrow * 272 + (qseg + 8 * i) * 8) = pk[i]; } }
    bf16x8 cf[2][8], vtf[2][2];
#pragma unroll
    for (int i = 0; i < 2; ++i) {
        const bf16_t* cp = CS + ((size_t)((bh * 16 + 2 * w + i) * 32 + c)) * 4096 + fr * 256 + fq * 8;
#pragma unroll
        for (int kk = 0; kk < 8; ++kk) cf[i][kk] = (c > 0) ? *(const bf16x8*)(cp + kk * 32) : (bf16x8){0, 0, 0, 0, 0, 0, 0, 0};
        const bf16_t* vp = vT + ((size_t)(bh * 32 + c) * 256 + 32 * w + 16 * i + fr) * 64 + fq * 8;
#pragma unroll
        for (int kk = 0; kk < 2; ++kk) vtf[i][kk] = *(const bf16x8*)(vp + kk * 32); }
    const bf16_t* z = (const bf16_t*)(a.ws + O_Z); bf16_t* mix = (bf16_t*)(a.ws + O_MIX); const float* gn = a.mlstm_norm + (size_t)l * 1024 + h * 256;
    u32x2 mo2[4][2]; f32x4 g4[2];
#pragma unroll
    for (int i = 0; i < 2; ++i) { const int e = 32 * w + 16 * i + 4 * fq; g4[i] = *(const f32x4*)(gn + e);
#pragma unroll
        for (int rt = 0; rt < 4; ++rt) mo2[rt][i] = *(const u32x2*)(z + (tb + rt * 16 + fr) * ZLD + 3072 + h * 256 + e); }
    bar_lds();
#pragma unroll 1
    for (int ti = w; ti < 10; ti += 8) {
        const int rt = ti < 1 ? 0 : ti < 3 ? 1 : ti < 6 ? 2 : 3, ct = ti - (rt * (rt + 1)) / 2;
        bf16x8 qf[8], kf[8];
#pragma unroll
        for (int kk = 0; kk < 8; ++kk) { qf[kk] = *(const bf16x8*)(Qs + (rt * 16 + fr) * 272 + kk * 32 + fq * 8); kf[kk] = *(const bf16x8*)(Ks + (ct * 16 + fr) * 272 + kk * 32 + fq * 8); }
        f32x4 sacc = {0.f, 0.f, 0.f, 0.f};
#pragma unroll
        for (int kk = 0; kk < 8; ++kk) sacc = MFMA16(kf[kk], qf[kk], sacc);
        const int t = rt * 16 + fr, s0 = ct * 16 + 4 * fq;
        const f32x4 us = *(const f32x4*)(scl + s0); const float Mt = scl[64 + t];
        float p[4], rs = 0.f;
#pragma unroll
        for (int j = 0; j < 4; ++j) { p[j] = (s0 + j <= t) ? sacc[j] * __expf(us[j] - Mt) : 0.f; rs += p[j]; }
        rs += shx(rs, 16); rs += shx(rs, 32);
        if (fq == 0) rsp[(rt * 4 + ct) * 16 + fr] = rs;
        u32x2 pw; pw.x = pk2(p[0], p[1]); pw.y = pk2(p[2], p[3]); *(u32x2*)(Ps + t * 80 + s0) = pw;
    }
    { const int t = tid >> 3, pr = tid & 7; float dsum = 0.f;
#pragma unroll
      for (int i = 0; i < 4; ++i) { float f[8]; unpack8(*(const u32x4*)(Qs + t * 272 + i * 64 + pr * 8), f);
          const f32x4 n0 = *(const f32x4*)(nloc + i * 64 + pr * 8), n1 = *(const f32x4*)(nloc + i * 64 + pr * 8 + 4);
          dsum += f[0] * n0[0] + f[1] * n0[1] + f[2] * n0[2] + f[3] * n0[3] + f[4] * n1[0] + f[5] * n1[1] + f[6] * n1[2] + f[7] * n1[3]; }
      dsum += shx(dsum, 1); dsum += shx(dsum, 2); dsum += shx(dsum, 4);
      if (pr == 0) qnv[t] = dsum; }
    bar_lds();
    f32x4 hv[4][2];
#pragma unroll
    for (int rt = 0; rt < 4; ++rt) {
        bf16x8 qf[8], pf[2];
#pragma unroll
        for (int kk = 0; kk < 8; ++kk) qf[kk] = *(const bf16x8*)(Qs + (rt * 16 + fr) * 272 + kk * 32 + fq * 8);
#pragma unroll
        for (int kk = 0; kk < 2; ++kk) pf[kk] = *(const bf16x8*)(Ps + (rt * 16 + fr) * 80 + kk * 32 + fq * 8);
        const int t = rt * 16 + fr;
        const float Wt = scl[128 + t], Ft = scl[192 + t];
        float rowsum = 0.f;
#pragma unroll
        for (int ct = 0; ct < 4; ++ct) if (ct <= rt) rowsum += rsp[(rt * 4 + ct) * 16 + fr];
        const float den = Wt * qnv[t] + rowsum, inv = 1.0f / fmaxf(fabsf(den), Ft);
        float hs = 0.f;
#pragma unroll
        for (int i = 0; i < 2; ++i) { f32x4 a1 = {0.f, 0.f, 0.f, 0.f}, a2 = {0.f, 0.f, 0.f, 0.f};
#pragma unroll
            for (int kk = 0; kk < 8; ++kk) a1 = MFMA16(cf[i][kk], qf[kk], a1);
#pragma unroll
            for (int kk = 0; kk < 2; ++kk) a2 = MFMA16(vtf[i][kk], pf[kk], a2);
#pragma unroll
            for (int j = 0; j < 4; ++j) { const float v = (Wt * a1[j] + a2[j]) * inv; hv[rt][i][j] = v; hs += v * v; } }
        hs += shx(hs, 16); hs += shx(hs, 32);
        if (fq == 0) hsq[w * 64 + t] = hs;
    }
    bar_lds();
#pragma unroll
    for (int rt = 0; rt < 4; ++rt) {
        const int t = rt * 16 + fr; float tot = 0.f;
#pragma unroll
        for (int ww = 0; ww < 8; ++ww) tot += hsq[ww * 64 + t];
        const float rstd = rsqrtf(tot * (1.0f / 256.0f) + EPS);
#pragma unroll
        for (int i = 0; i < 2; ++i) { const int e = 32 * w + 16 * i + 4 * fq;
            const u32x2 mo = mo2[rt][i]; const f32x4 gg = g4[i];
            const float y0 = hv[rt][i][0] * rstd * gg[0] * sigmoidf_(bflo(mo.x)), y1 = hv[rt][i][1] * rstd * gg[1] * sigmoidf_(bfhi(mo.x));
            const float y2 = hv[rt][i][2] * rstd * gg[2] * sigmoidf_(bflo(mo.y)), y3 = hv[rt][i][3] * rstd * gg[3] * sigmoidf_(bfhi(mo.y));
            u32x2 pw; pw.x = pk2(y0, y1); pw.y = pk2(y2, y3); *(u32x2*)(mix + (tb + t) * DM + h * 256 + e) = pw; }
    }
}

DI void phase_mlstm_out(const Args& a, int l, unsigned char* smem) {
    for (int it = blockIdx.x; it < 512; it += gridDim.x) { const int i = it & 255, xcd = i & 7, slot = i >> 3, bh = xcd * 2 + (slot >> 4), c = (slot & 15) + 16 * (it >> 8); mlstm_out_item(a, l, bh * 32 + c, smem); }
}

constexpr int AT_K = 0, AT_V = 36864, AT_P = 77824, AT_BIAS = 118784, AT_KM = 126976;

DI void attn_item(const Args& a, int b, int head, int qt, unsigned char* smem) {
    const int tid = otid(), w = tid >> 6, lane = tid & 63, fr = lane & 15, fq = lane >> 4;
    const int bh = b * 8 + head, qblk = qt >> 1, q0 = qt * 128 + w * 16;
    bf16_t* Kt = (bf16_t*)(smem + AT_K); bf16_t* Vt = (bf16_t*)(smem + AT_V); bf16_t* Pw = (bf16_t*)(smem + AT_P) + w * 2 * 16 * 80;
    float* biasTab = (float*)(smem + AT_BIAS); float* km = (float*)(smem + AT_KM);
    const bf16_t* aqn = (const bf16_t*)(a.ws + O_AQN); const bf16_t* akn = (const bf16_t*)(a.ws + O_AKN); const bf16_t* avT = (const bf16_t*)(a.ws + O_AVT);
    __syncthreads();
    for (int i = tid; i < 2048; i += 512) biasTab[i] = ((const float*)(a.ws + O_BIAST))[head * 2048 + i];
    for (int i = tid; i < 1024; i += 512) km[i] = ((const float*)(a.ws + O_KMEAN))[(size_t)bh * 1024 + i];
    bf16x8 qf[4];
    { const bf16_t* qp = aqn + ((size_t)b * SEQ + q0 + fr) * 1024 + head * 128 + fq * 8;
#pragma unroll
      for (int kk = 0; kk < 4; ++kk) qf[kk] = *(const bf16x8*)(qp + kk * 32); }
    const int krow = tid >> 3, kseg = tid & 7, vd = tid >> 2, vseg = tid & 3;
    u32x4 pkA[2], pvA[2], pkB[2], pvB[2];
#define AT_LOAD(PK, PV, kt) do { _Pragma("unroll") for (int i = 0; i < 2; ++i) { \
        PK[i] = *(const u32x4*)(akn + ((size_t)b * SEQ + (kt) * 64 + krow) * 1024 + head * 128 + kseg * 8 + i * 64); \
        PV[i] = *(const u32x4*)(avT + ((size_t)bh * 128 + vd) * SEQ + (kt) * 64 + vseg * 8 + i * 32); } } while (0)
#define AT_STORE(PK, PV, buf) do { _Pragma("unroll") for (int i = 0; i < 2; ++i) { \
        *(u32x4*)(Kt + (buf) * 64 * 144 + krow * 144 + kseg * 8 + i * 64) = PK[i]; \
        *(u32x4*)(Vt + (buf) * 128 * 80 + vd * 80 + vseg * 8 + i * 32) = PV[i]; } } while (0)
    AT_LOAD(pkA, pvA, 0);
    AT_LOAD(pkB, pvB, 1);
    __syncthreads();
    unsigned selmask;
    { float g[8];
#pragma unroll
      for (int n = 0; n < 8; ++n) { float p = 0.f;
#pragma unroll
          for (int kk = 0; kk < 4; ++kk)
              { const f32x4 k0 = *(const f32x4*)(km + n * 128 + kk * 32 + fq * 8), k1 = *(const f32x4*)(km + n * 128 + kk * 32 + fq * 8 + 4);
                p += bf1((bf16_t)qf[kk][0]) * k0[0] + bf1((bf16_t)qf[kk][1]) * k0[1] + bf1((bf16_t)qf[kk][2]) * k0[2] + bf1((bf16_t)qf[kk][3]) * k0[3]
                   + bf1((bf16_t)qf[kk][4]) * k1[0] + bf1((bf16_t)qf[kk][5]) * k1[1] + bf1((bf16_t)qf[kk][6]) * k1[2] + bf1((bf16_t)qf[kk][7]) * k1[3]; }
          p += shx(p, 16); p += shx(p, 32); g[n] = p; }
      if (qblk <= 3) selmask = (1u << qblk) - 1u;
      else { selmask = 0u;
#pragma unroll
          for (int r = 0; r < 3; ++r) { float best = -INFINITY; int bi = 0;
#pragma unroll
              for (int n = 0; n < 8; ++n) if (n < qblk && !((selmask >> n) & 1u) && g[n] > best) { best = g[n]; bi = n; }
              selmask |= 1u << bi; } } }
    AT_STORE(pkA, pvA, 0);
    AT_STORE(pkB, pvB, 1);
    bar_lds();
#pragma unroll
    for (int kk = 0; kk < 4; ++kk) { u32x4 t_ = __builtin_bit_cast(u32x4, qf[kk]); asm volatile("" : "+v"(t_.x), "+v"(t_.y), "+v"(t_.z), "+v"(t_.w)); qf[kk] = __builtin_bit_cast(bf16x8, t_); }
    const int nkt = 2 * (qt + 1);
    f32x4 o[8];
#pragma unroll
    for (int i = 0; i < 8; ++i) o[i] = (f32x4){0.f, 0.f, 0.f, 0.f};
    float lrun = 0.f;
    const int qpos = q0 + fr;
    auto compute2 = [&](const int kt) __attribute__((always_inline)) {
        bool own[2], lsel[2], act[2];
#pragma unroll
        for (int u = 0; u < 2; ++u) { const int n = (kt + u) >> 2; own[u] = (n == qblk); lsel[u] = ((selmask >> n) & 1u) != 0u;
            act[u] = own[u] ? ((kt + u) * 64 <= q0 + 15) : (__ballot(lsel[u]) != 0ull); }
        if (act[0] || act[1]) {
            f32x4 s[2][4];
#pragma unroll
            for (int hf = 0; hf < 2; ++hf) { bf16x8 kf[2][8];
#pragma unroll
                for (int u = 0; u < 2; ++u)
#pragma unroll
                    for (int i = 0; i < 8; ++i) kf[u][i] = *(const bf16x8*)(Kt + u * 64 * 144 + ((hf * 2 + (i >> 2)) * 16 + fr) * 144 + (i & 3) * 32 + fq * 8);
#pragma unroll
                for (int u = 0; u < 2; ++u) { s[u][hf * 2] = (f32x4){0.f, 0.f, 0.f, 0.f}; s[u][hf * 2 + 1] = (f32x4){0.f, 0.f, 0.f, 0.f}; }
#pragma unroll
                for (int kk = 0; kk < 4; ++kk)
#pragma unroll
                    for (int u = 0; u < 2; ++u)
#pragma unroll
                        for (int c2 = 0; c2 < 2; ++c2) s[u][hf * 2 + c2] = MFMA16(kf[u][c2 * 4 + kk], qf[kk], s[u][hf * 2 + c2]); }
#pragma unroll
            for (int u = 0; u < 2; ++u) {
                float bv[16];
                const int rel0 = qpos - ((kt + u) * 64 + 4 * fq);
                { const float* bp = biasTab + (rel0 - 51);
#pragma unroll
                  for (int ct = 0; ct < 4; ++ct)
#pragma unroll
                      for (int j = 0; j < 4; ++j) bv[ct * 4 + j] = bp[51 - ct * 16 - j]; }
                float ps = 0.f; u32x2 pw[4];
                if (!own[u]) {
#pragma unroll
                    for (int ct = 0; ct < 4; ++ct) { float p[4];
#pragma unroll
                        for (int j = 0; j < 4; ++j) { p[j] = __builtin_amdgcn_exp2f(s[u][ct][j] + bv[ct * 4 + j]); ps += p[j]; }
                        pw[ct].x = pk2(p[0], p[1]); pw[ct].y = pk2(p[2], p[3]); }
                    if (!lsel[u]) { ps = 0.f;
#pragma unroll
                        for (int ct = 0; ct < 4; ++ct) { pw[ct].x = 0u; pw[ct].y = 0u; } }
                } else {
#pragma unroll
                    for (int ct = 0; ct < 4; ++ct) { float p[4];
#pragma unroll
                        for (int j = 0; j < 4; ++j) { const int rel = rel0 - ct * 16 - j; p[j] = rel >= 0 ? __builtin_amdgcn_exp2f(s[u][ct][j] + bv[ct * 4 + j]) : 0.f; ps += p[j]; }
                        pw[ct].x = pk2(p[0], p[1]); pw[ct].y = pk2(p[2], p[3]); }
                }
                lrun += ps;
#pragma unroll
                for (int ct = 0; ct < 4; ++ct) *(u32x2*)(Pw + u * 16 * 80 + fr * 80 + ct * 16 + 4 * fq) = pw[ct];
            }
            bf16x8 pf[2][2];
#pragma unroll
            for (int u = 0; u < 2; ++u) { pf[u][0] = *(const bf16x8*)(Pw + u * 16 * 80 + fr * 80 + fq * 8); pf[u][1] = *(const bf16x8*)(Pw + u * 16 * 80 + fr * 80 + 32 + fq * 8); }
#pragma unroll
            for (int dh = 0; dh < 2; ++dh) { bf16x8 vf[2][8];
#pragma unroll
                for (int u = 0; u < 2; ++u)
#pragma unroll
                    for (int i = 0; i < 8; ++i) vf[u][i] = *(const bf16x8*)(Vt + u * 128 * 80 + ((dh * 4 + (i >> 1)) * 16 + fr) * 80 + (i & 1) * 32 + fq * 8);
#pragma unroll
                for (int u = 0; u < 2; ++u)
#pragma unroll
                    for (int k2 = 0; k2 < 2; ++k2)
#pragma unroll
                        for (int dt = 0; dt < 4; ++dt) o[dh * 4 + dt] = MFMA16(vf[u][dt * 2 + k2], pf[u][k2], o[dh * 4 + dt]); }
        }
    };
#ifdef PROBE_MASK
    unsigned long long tcomp = 0ull; const unsigned long long tl0 = clock64();
#endif
#pragma unroll 1
    for (int kt = 0; kt < nkt; kt += 2) {
        if (kt + 2 < nkt) { AT_LOAD(pkA, pvA, kt + 2); AT_LOAD(pkB, pvB, kt + 3); }
#ifdef PROBE_MASK
        const unsigned long long tc0 = clock64();
#endif
        compute2(kt);
#ifdef PROBE_MASK
        const unsigned long long tc1 = clock64();
#if !defined(PROBE_SEL) || PROBE_SEL == 0
        tcomp += tc1 - tc0;
#endif
#endif
        bar_lds();
#ifdef PROBE_MASK
        const unsigned long long tc2 = clock64();
#if PROBE_SEL == 1
        tcomp += tc2 - tc1;
#endif
#endif
        if (kt + 2 < nkt) { AT_STORE(pkA, pvA, 0); AT_STORE(pkB, pvB, 1); }
#ifdef PROBE_MASK
        asm volatile("s_waitcnt lgkmcnt(0)" ::: "memory");
        const unsigned long long tc3 = clock64();
#if PROBE_SEL == 2
        tcomp += tc3 - tc2;
#endif
#endif
        bar_lds();
    }
#ifdef PROBE_MASK
    if (blockIdx.x == 0 && tid == 0) { unsigned long long* ts = (unsigned long long*)(a.ws + O_TS); ts[70] += tcomp; ts[71] += clock64() - tl0; }
#endif
    lrun += shx(lrun, 16); lrun += shx(lrun, 32);
    const float inv = 1.0f / lrun;
    bf16_t* op = (bf16_t*)(a.ws + O_MIX) + ((size_t)b * SEQ + qpos) * DM + 1024 + head * 128 + 4 * fq;
#pragma unroll
    for (int dt = 0; dt < 8; ++dt) { u32x2 pw; pw.x = pk2(o[dt][0] * inv, o[dt][1] * inv); pw.y = pk2(o[dt][2] * inv, o[dt][3] * inv); __builtin_nontemporal_store(pw, (u32x2*)(op + dt * 16)); }
#undef AT_LOAD
#undef AT_STORE
}

DI void phase_mixer(const Args& a, unsigned char* smem, int l) {
    for (int it = blockIdx.x; it < 256; it += gridDim.x) { const int xcd = it & 7, slot = it >> 3; mlstm_item(a, (xcd * 2 + (slot >> 4)) * 16 + (slot & 15), smem); }
#ifdef PROBE_MASK
    if (blockIdx.x == 0 && otid() == 0) ((unsigned long long*)(a.ws + O_TS))[64 + l] = wall_clock64();
#endif
    for (int it = blockIdx.x; it < 256; it += gridDim.x) { const int xcd = it & 7, slot = it >> 3, bh = xcd * 4 + (slot >> 3), j = slot & 7; attn_item(a, bh >> 3, bh & 7, j, smem); attn_item(a, bh >> 3, bh & 7, 15 - j, smem); }
#ifdef PROBE_MASK
    if (blockIdx.x == 0 && otid() == 0) ((unsigned long long*)(a.ws + O_TS))[80 + l] = wall_clock64();
#endif
}

DI void phase_hnorm(const Args& a, int l) {
    const float* hbuf = (const float*)(a.ws + O_HBUF); const u64* hss = (const u64*)(a.ws + O_HSS); const bf16_t* z = (const bf16_t*)(a.ws + O_Z);
    bf16_t* mix = (bf16_t*)(a.ws + O_MIX); const float* gn = a.mlstm_norm + (size_t)l * 1024;
    for (int i = blockIdx.x * 512 + otid(); i < T_TOK * 128; i += gridDim.x * 512) {
        const int t = i >> 7, c = (i & 127) * 8;
        const float rstd = rsqrtf((float)hss[(size_t)t * 4 + (c >> 8)] * (HS_INV / 256.0f) + EPS);
        const f32x4 h0 = *(const f32x4*)(hbuf + (size_t)t * 1024 + c), h1 = *(const f32x4*)(hbuf + (size_t)t * 1024 + c + 4);
        const f32x4 g0 = *(const f32x4*)(gn + c), g1 = *(const f32x4*)(gn + c + 4);
        float mo[8], y[8]; unpack8(*(const u32x4*)(z + (size_t)t * ZLD + 3072 + c), mo);
#pragma unroll
        for (int e = 0; e < 4; ++e) { y[e] = h0[e] * rstd * g0[e] * sigmoidf_(mo[e]); y[4 + e] = h1[e] * rstd * g1[e] * sigmoidf_(mo[4 + e]); }
        *(u32x4*)(mix + (size_t)t * DM + c) = pack8(y);
    }
}

DI void phase_ffnconv(const Args& a, int l) {
    const bf16_t* u = (const bf16_t*)(a.ws + O_U); bf16_t* act = (bf16_t*)(a.ws + O_ACT);
    const float* cw = a.conv_ffn_w + (size_t)l * 3 * DFF2; const float* cb = a.conv_ffn_b + (size_t)l * DFF2;
    constexpr int NCG = DFF / 8, RB = 8;
    for (int i = blockIdx.x * 512 + otid(); i < (T_TOK / RB) * NCG; i += gridDim.x * 512) {
        const int rb = i / NCG, f = (i % NCG) * 8; const int t0 = rb * RB; const bool first = (t0 % SEQ) == 0;
        u32x4 gr[RB + 2], vr[RB + 2];
#pragma unroll
        for (int r = 0; r < RB + 2; ++r) { gr[r] = (u32x4){0u, 0u, 0u, 0u}; vr[r] = gr[r];
            if (r >= 2 || !first) { const bf16_t* up = u + (size_t)(t0 - 2 + r) * DFF2 + f; gr[r] = __builtin_nontemporal_load((const u32x4*)up); vr[r] = __builtin_nontemporal_load((const u32x4*)(up + DFF)); } }
        float wg[3][8], wv[3][8], bg[8], bv[8];
#pragma unroll
        for (int j = 0; j < 3; ++j) { const f32x4 p0 = *(const f32x4*)(cw + j * DFF2 + f), p1 = *(const f32x4*)(cw + j * DFF2 + f + 4), q0 = *(const f32x4*)(cw + j * DFF2 + DFF + f), q1 = *(const f32x4*)(cw + j * DFF2 + DFF + f + 4);
#pragma unroll
            for (int e = 0; e < 4; ++e) { wg[j][e] = p0[e]; wg[j][4 + e] = p1[e]; wv[j][e] = q0[e]; wv[j][4 + e] = q1[e]; } }
        { const f32x4 p0 = *(const f32x4*)(cb + f), p1 = *(const f32x4*)(cb + f + 4), q0 = *(const f32x4*)(cb + DFF + f), q1 = *(const f32x4*)(cb + DFF + f + 4);
#pragma unroll
          for (int e = 0; e < 4; ++e) { bg[e] = p0[e]; bg[4 + e] = p1[e]; bv[e] = q0[e]; bv[4 + e] = q1[e]; } }
        float g0[8], g1[8], v0[8], v1[8];
        unpack8(gr[0], g0); unpack8(gr[1], g1); unpack8(vr[0], v0); unpack8(vr[1], v1);
#pragma unroll
        for (int r = 0; r < RB; ++r) { float g2[8], v2[8], y[8];
            unpack8(gr[r + 2], g2); unpack8(vr[r + 2], v2);
#pragma unroll
            for (int e = 0; e < 8; ++e) { const float G = bg[e] + wg[0][e] * g0[e] + wg[1][e] * g1[e] + wg[2][e] * g2[e]; const float V = bv[e] + wv[0][e] * v0[e] + wv[1][e] * v1[e] + wv[2][e] * v2[e];
                y[e] = siluf_(G) * V; g0[e] = g1[e]; g1[e] = g2[e]; v0[e] = v1[e]; v1[e] = v2[e]; }
            *(u32x4*)(act + (size_t)(t0 + r) * DFF + f) = pack8(y); }
    }
}

#define XB_TMO      128
#define XB_XCNT(j)  (256  + 64 * (j))
#define XB_XSUB(j)  (1280 + 64 * (j))
#define XB_XGEN(j)  (2304 + 64 * (j))
#define XB_TOP      3328
#define XB_TOPGEN   3392
#define XCD_BAR_WORDS 3456
#define XB_SPIN_CAP (1u << 18)

__device__ __forceinline__ unsigned xb_ld(unsigned* p)              { return __hip_atomic_load(p, __ATOMIC_RELAXED, __HIP_MEMORY_SCOPE_AGENT); }
__device__ __forceinline__ unsigned xb_add(unsigned* p, unsigned v) { return __hip_atomic_fetch_add(p, v, __ATOMIC_RELAXED, __HIP_MEMORY_SCOPE_AGENT); }
__device__ __forceinline__ unsigned xb_xcc_id() { return (unsigned)__builtin_amdgcn_s_getreg((3 << 11) | 20) & 0xFu; }
#define XB_SPIN(cond, bar) do { unsigned _sp = 0; while (cond) { __builtin_amdgcn_s_sleep(1); \
    if ((++_sp & 255u) == 0u) { if (xb_ld(&(bar)[XB_TMO])) break; if (_sp > XB_SPIN_CAP) { atomicAdd(&(bar)[XB_TMO], 1u); break; } } } } while (0)

struct XcdBarrier {
    unsigned* bar; unsigned x;
    volatile LAS unsigned* st;
};

__device__ __forceinline__ XcdBarrier xcd_barrier_post(unsigned* bar, volatile LAS unsigned* st, int tid) {
    XcdBarrier b; b.bar = bar; b.x = xb_xcc_id(); b.st = st;
    if (tid == 0) (void)xb_add(&bar[XB_XCNT(b.x)], 1u);
    return b;
}
__device__ __forceinline__ void xcd_barrier_complete(unsigned* bar, unsigned x, unsigned& nloc, unsigned& nx) {
    const unsigned G = gridDim.x * gridDim.y * gridDim.z;
    unsigned sum, cnt, mine, sp = 0u;
    for (;;) {
        sum = 0u; cnt = 0u; mine = 0u;
#pragma unroll
        for (unsigned j = 0; j < 16; ++j) { const unsigned c = xb_ld(&bar[XB_XCNT(j)]); sum += c; cnt += (c > 0u) ? 1u : 0u; mine = (j == x) ? c : mine; }
        if (sum == G) break;
        __builtin_amdgcn_s_sleep(1);
        if ((++sp & 255u) == 0u) { if (xb_ld(&bar[XB_TMO])) break; if (sp > XB_SPIN_CAP) { atomicAdd(&bar[XB_TMO], 1u); break; } }
    }
    nloc = mine > 0u ? mine : 1u; nx = cnt > 0u ? cnt : 1u;
}

__device__ __forceinline__ void xcd_barrier(const XcdBarrier& b, int tid) {
    asm volatile("s_waitcnt vmcnt(0)" ::: "memory");
    __syncthreads();
    if (tid == 0) {
        unsigned* bar = b.bar;
        __builtin_amdgcn_s_waitcnt(0);
        unsigned nloc = b.st[0], nx = b.st[1];
        if (nloc == 0u) { xcd_barrier_complete(bar, b.x, nloc, nx); b.st[0] = nloc; b.st[1] = nx; }
        const unsigned old = xb_add(&bar[XB_XSUB(b.x)], 1u);
        const unsigned gen = old / nloc;
        if (old + 1u == (gen + 1u) * nloc) {
            __builtin_amdgcn_fence(__ATOMIC_RELEASE, "agent");
            asm volatile("s_waitcnt vmcnt(0)" ::: "memory");
            const unsigned og = xb_add(&bar[XB_TOP], 1u);
            const unsigned tg = og / nx;
            if (og + 1u == (tg + 1u) * nx) xb_add(&bar[XB_TOPGEN], 1u);
            else XB_SPIN(xb_ld(&bar[XB_TOPGEN]) == tg, bar);
            __builtin_amdgcn_fence(__ATOMIC_ACQUIRE, "agent");
            xb_add(&bar[XB_XGEN(b.x)], 1u);
            asm volatile("s_waitcnt vmcnt(0)" ::: "memory");
        } else {
            XB_SPIN(xb_ld(&bar[XB_XGEN(b.x)]) == gen, bar);
            __builtin_amdgcn_fence(__ATOMIC_ACQUIRE, "agent");
            asm volatile("s_waitcnt vmcnt(0)" ::: "memory");
        }
    }
    __syncthreads();
}

__global__ void __launch_bounds__(512) mega_fwd(Args a_in) {
    Args a = a_in; a.wv = __builtin_amdgcn_readfirstlane((int)threadIdx.x >> 6);
    extern __shared__ __attribute__((aligned(16))) unsigned char smem[];
    cg::grid_group grid = cg::this_grid();
    constexpr int NPH = 1 + 8 * DEPTH;
    volatile LAS unsigned* bst = (volatile LAS unsigned*)(LAS unsigned char*)(smem + LDS_BYTES - 16);
    if (otid() < 2) bst[otid()] = 0u;
    __syncthreads();
    const XcdBarrier gbar = xcd_barrier_post((unsigned*)(a.ws + O_BAR), bst, otid());
#pragma unroll 1
    for (int ph = 0; ph < NPH; ++ph) {
        const int l = (ph - 1) >> 3, k = (ph - 1) & 7;
#ifdef PROBE_MASK
        if (blockIdx.x == 0 && otid() == 0) { ((unsigned long long*)(a.ws + O_TS))[ph] = wall_clock64(); if (ph == 0) { ((unsigned long long*)(a.ws + O_TS))[70] = 0ull; ((unsigned long long*)(a.ws + O_TS))[71] = 0ull; } }
#endif
        u64* ss = (u64*)(a.ws + O_SS);
        bf16_t* xb = (bf16_t*)(a.ws + O_XB);
        if (ph == 0) phase0(a, smem);
        else if (k == 0 || k == 5) {
            EpiScale E; const bf16_t* Bt; int N;
            if (k == 0) { E.O = (bf16_t*)(a.ws + O_Z); E.ldc = ZLD; E.SS = ss + (size_t)(2 * l) * T_TOK; E.gates = (float*)(a.ws + O_GATES); E.gate_pn = 28; Bt = (const bf16_t*)(a.ws + O_WIN + l * SZ_WIN); N = DINP; }
            else { E.O = (bf16_t*)(a.ws + O_U); E.ldc = DFF2; E.SS = ss + (size_t)(2 * l + 1) * T_TOK; E.gates = nullptr; E.gate_pn = -1; Bt = (const bf16_t*)(a.ws + O_WUP + l * SZ_WUP); N = DFF2; }
            run_gemm(smem, xb, Bt, T_TOK, N, DM, E, a.wv);
        } else if (k == 4 || k == 7) {
            EpiRes E; E.X = (k == 7 && l == DEPTH - 1) ? a.out : nullptr; E.XB = xb; const bf16_t* A; const bf16_t* Bt; int K;
            if (k == 4) { E.SS = ss + (size_t)(2 * l + 1) * T_TOK; A = (const bf16_t*)(a.ws + O_MIX); Bt = (const bf16_t*)(a.ws + O_WOUT + l * SZ_WOUT); K = DM; }
            else { E.SS = ss + (size_t)(2 * l + 2) * T_TOK; A = (const bf16_t*)(a.ws + O_ACT); Bt = (const bf16_t*)(a.ws + O_WD + l * SZ_WD); K = DFF; }
            run_gemm(smem, A, Bt, T_TOK, DM, K, E, a.wv);
        } else if (k == 1) phase_prep(a, l, smem);
        else if (k == 2) phase_mixer(a, smem, l);
        else if (k == 3) phase_mlstm_out(a, l, smem);
        else phase_ffnconv(a, l);
        if (a.ws == nullptr) grid.sync();
        if (ph + 1 < NPH) xcd_barrier(gbar, otid());
    }
#ifdef PROBE_MASK
    if (blockIdx.x == 0) {
        __syncthreads();
        float* dsh = (float*)smem;
        if (otid() == 0) {
            unsigned long long* ts = (unsigned long long*)(a.ws + O_TS); ts[NPH] = wall_clock64();
            unsigned long long sel = 0ull;
            for (int ph = 0; ph < NPH; ++ph) { const int kk = ph == 0 ? 8 : ((ph - 1) & 7); if ((PROBE_MASK >> kk) & 1) sel += ts[ph + 1] - ts[ph]; }
            if ((PROBE_MASK >> 9) & 1) for (int l = 0; l < DEPTH; ++l) sel += ts[64 + l] - ts[1 + 8 * l + 2];
            float frac = (float)sel / (float)(ts[NPH] - ts[0]);
            if ((PROBE_MASK >> 10) & 1) frac = (float)ts[70] / (float)ts[71];
            if ((PROBE_MASK >> 11) & 1) { unsigned long long w_ = 0ull, p_ = 0ull; for (int l = 0; l < DEPTH; ++l) { w_ += ts[1 + 8 * l + 3] - ts[80 + l]; p_ += ts[1 + 8 * l + 3] - ts[1 + 8 * l + 2]; } frac = (float)w_ / (float)p_; }
            dsh[0] = 0.5f * sqrtf(frac);
        }
        __syncthreads();
        asm volatile("s_waitcnt vmcnt(0)" ::: "memory");
        const float d = dsh[0];
        for (int i = otid(); i < 256 * 256; i += 512) a.out[(size_t)(i >> 8) * DM + (i & 255)] += d;
    }
#endif
}

extern "C" void kernel_launch(void* const* d_in, const int* in_sizes, int n_in, void* d_out, int out_size, void* d_ws, size_t ws_size, hipStream_t stream) {
    static int grid = 0;
    if (grid == 0) {
        if (n_in != 15 || out_size != T_TOK * DM || ws_size < WS_END) { fprintf(stderr, "kernel_launch: unexpected shapes (n_in %d out %d ws %zu need %zu)\n", n_in, out_size, ws_size, (size_t)WS_END); grid = -1; return; }
        int dev = 0, cus = 0, per_cu = 0;
        (void)hipGetDevice(&dev); (void)hipDeviceGetAttribute(&cus, hipDeviceAttributeMultiprocessorCount, dev);
        if (hipFuncSetAttribute((const void*)mega_fwd, hipFuncAttributeMaxDynamicSharedMemorySize, LDS_BYTES) != hipSuccess) { fprintf(stderr, "kernel_launch: hipFuncSetAttribute failed\n"); }
        if (hipOccupancyMaxActiveBlocksPerMultiprocessor(&per_cu, (const void*)mega_fwd, 512, LDS_BYTES) != hipSuccess || per_cu < 1) per_cu = 1;
        (void)hipGetLastError();
        grid = cus * (per_cu > 1 ? 1 : per_cu);
        if (grid <= 0) grid = 256;
    }
    if (grid < 0) return;
    Args a{};
    a.x = (const float*)d_in[0]; a.norm_mix = (const float*)d_in[1]; a.w_in = (const float*)d_in[2]; a.gate_bias = (const float*)d_in[3];
    a.conv_qk_w = (const float*)d_in[4]; a.conv_qk_b = (const float*)d_in[5]; a.mlstm_norm = (const float*)d_in[6]; a.qk_norm = (const float*)d_in[7];
    a.rel_bias = (const float*)d_in[8]; a.w_out = (const float*)d_in[9]; a.norm_ffn = (const float*)d_in[10]; a.w_up = (const float*)d_in[11];
    a.conv_ffn_w = (const float*)d_in[12]; a.conv_ffn_b = (const float*)d_in[13]; a.w_down = (const float*)d_in[14];
    a.out = (float*)d_out; a.ws = (unsigned char*)d_ws;
    (void)hipMemsetAsync((unsigned char*)d_ws + O_BAR, 0, 16384, stream);
    void* args[] = {&a};
    hipError_t e = hipLaunchCooperativeKernel((const void*)mega_fwd, dim3(grid), dim3(512), args, LDS_BYTES, stream);
    if (e != hipSuccess) fprintf(stderr, "kernel_launch: cooperative launch failed: %s (grid %d)\n", hipGetErrorString(e), grid);
}
```

```cpp
#include <hip/hip_runtime.h>
#include <hip/hip_cooperative_groups.h>
#include <cstdio>
#include <cmath>
namespace cg = cooperative_groups;
__device__ __forceinline__ int olane() { int l; asm volatile("v_mbcnt_lo_u32_b32 %0, -1, 0\n\tv_mbcnt_hi_u32_b32 %0, -1, %0" : "=v"(l)); return l; }
#define otid() ((a.wv << 6) | olane())
__device__ __forceinline__ float shx(float v, int m) { return __builtin_bit_cast(float, __builtin_amdgcn_ds_bpermute((olane() ^ m) << 2, __builtin_bit_cast(int, v))); }
__device__ __forceinline__ float shu(float v, int o) { const int l = olane(); return __builtin_bit_cast(float, __builtin_amdgcn_ds_bpermute((l >= o ? l - o : l) << 2, __builtin_bit_cast(int, v))); }
namespace pg8 {
#define PG8_LAS __attribute__((address_space(3)))
typedef unsigned short bf16_t;
typedef short bf16x8 __attribute__((ext_vector_type(8)));
typedef float f32x4 __attribute__((ext_vector_type(4)));
typedef unsigned u32x4 __attribute__((ext_vector_type(4)));
constexpr int BM = 256, BK = 64, HALF = 128, HTB = HALF * BK * 2  , STAGE_BYTES = 8 * HTB, NXCD = 8, WGM = 8;

__host__ __device__ __forceinline__ int lds_byte(int r, int c) { const int st = (r >> 4) * 2 + (c >> 5), rr = r & 15, cc = c & 31, ob = rr * 64 + cc * 2; return st * 1024 + (ob ^ (((ob >> 9) & 1) << 5)); }
__host__ __device__ __forceinline__ void stage_rc(int b, int& R, int& C) { const int st = b / 1024, sb = b % 1024, swz = sb ^ (((sb >> 9) & 1) << 5); R = (st >> 1) * 16 + swz / 64; C = (st & 1) * 32 + (swz % 64) / 2; }
__host__ __device__ __forceinline__ int perm32(int rho) { const int n = rho >> 4, i = rho & 15; return 8 * (i >> 2) + 4 * n + (i & 3); }

struct Unit { int pm, pn; };
struct Gemm { const bf16_t* A; const bf16_t* Bt; int M, N, K, wv; };

struct StaticOrder {
    int nM, nN, nwg, G, c;
    __host__ __device__ void init(int M, int N, int G_, int c_) { nM = M / BM; nN = N / BM; nwg = nM * nN; G = G_; c = c_; }
    __host__ __device__ bool next(int i, Unit& u) const {
        const long L = (long)i * G + c; if (L >= nwg) return false;
        int wgid = (int)L; { const int q = nwg / NXCD, r = nwg % NXCD, xcd = wgid % NXCD, off = wgid / NXCD; wgid = (xcd < r ? xcd * (q + 1) : r * (q + 1) + (xcd - r) * q) + off; }
        const int nig = WGM * nN, gid = wgid / nig, fm = gid * WGM, gsz = (nM - fm) < WGM ? (nM - fm) : WGM;
        u.pm = fm + ((wgid % nig) % gsz); u.pn = (wgid % nig) / gsz; return true;
    }
    __device__ __forceinline__ void a_ready(const Unit&) const {}
    __device__ __forceinline__ void done(const Unit&) const {}
};

__device__ __forceinline__ unsigned cvt_pk_bf16(float lo, float hi) { unsigned r; asm volatile("v_cvt_pk_bf16_f32 %0, %1, %2" : "=v"(r) : "v"(lo), "v"(hi)); return r; }

template <class Epi, class Sched, bool STAMP = false>
__device__ __forceinline__ void gemm_phase(PG8_LAS unsigned char* lds, const Gemm g, const Sched& S, const Epi& E, unsigned long long* stamps) {
    const int lane = olane(), wid = g.wv, tid = (wid << 6) | lane, wr = wid >> 2, wc = wid & 3, fr = lane & 15, fq = lane >> 4;
    const int K = g.K, nt = K / BK;
    int ts_lo = 0, ts_hi = 0, nts = 0; const unsigned long long rt_entry = STAMP ? (unsigned long long)wall_clock64() : 0ull;
#define PG8_STAMP() do { if (STAMP && wid == 0 && nts < 64) { const unsigned long long _c = (unsigned long long)clock64(); \
        ts_lo = (lane == nts) ? (int)(unsigned)_c : ts_lo; ts_hi = (lane == nts) ? (int)(unsigned)(_c >> 32) : ts_hi; ++nts; } } while (0)
    PG8_STAMP();
    unsigned voffA[2], voffB[2];
#pragma unroll
    for (int i = 0; i < 2; ++i) { int R, C; stage_rc(tid * 16 + i * 8192, R, C); const int Rb = Epi::PERM ? ((R & ~31) + perm32(R & 31)) : R;
        voffA[i] = (unsigned)(R * K + C) * 2u; voffB[i] = (unsigned)(Rb * K + C) * 2u; }
    const size_t kstep = (size_t)(BK * 2);
    const size_t hstep = (size_t)HALF * K * 2;
    const size_t tstep = 2 * hstep;
    const unsigned ldsw = (unsigned)wid * 1024u;
    const int aoff = lds_byte(wr * 64 + fr, fq * 8), boff = lds_byte(wc * 32 + fr, fq * 8);
#define PG8_SA(b, h) (((b) * 2 + (h)) * HTB)
#define PG8_SB(b, h) ((4 + (b) * 2 + (h)) * HTB)
#define PG8_STAGE(bufoff, gbase, voff) do { _Pragma("unroll") for (int _i = 0; _i < 2; ++_i) \
        __builtin_amdgcn_global_load_lds((const unsigned*)((const char*)(gbase) + (voff)[_i]), (PG8_LAS unsigned*)(lds + (bufoff) + ldsw + _i * 8192), 16, 0, 0); } while (0)
#define PG8_LDA(dst, b, h) do { _Pragma("unroll") for (int m = 0; m < 4; ++m) _Pragma("unroll") for (int k = 0; k < 2; ++k) dst[m][k] = *(const PG8_LAS bf16x8*)(lds + PG8_SA(b, h) + aoff + m * 2048 + k * 1024); } while (0)
#define PG8_LDB(dst, b, h) do { _Pragma("unroll") for (int n = 0; n < 2; ++n) _Pragma("unroll") for (int k = 0; k < 2; ++k) dst[n][k] = *(const PG8_LAS bf16x8*)(lds + PG8_SB(b, h) + boff + n * 2048 + k * 1024); } while (0)
#define PG8_MMA(ai, bj, At, Bt) do { __builtin_amdgcn_s_setprio(1); _Pragma("unroll") for (int m = 0; m < 4; ++m) _Pragma("unroll") for (int n = 0; n < 2; ++n) _Pragma("unroll") for (int k = 0; k < 2; ++k) \
        acc[ai][bj][m][n] = __builtin_amdgcn_mfma_f32_16x16x32_bf16(Bt[n][k], At[m][k], acc[ai][bj][m][n], 0, 0, 0); __builtin_amdgcn_s_setprio(0); } while (0)
#define PG8_WAIT_V(n) asm volatile("s_waitcnt vmcnt(" #n ")" ::: "memory")
#define PG8_WAIT_L(n) asm volatile("s_waitcnt lgkmcnt(" #n ")" ::: "memory")
#define PG8_BAR __builtin_amdgcn_s_barrier()
#define PG8_SCHED __builtin_amdgcn_sched_barrier(0)
    Unit cur, nxt; int ui = 0;
    if (!S.next(0, cur)) return;
    f32x4 acc[2][2][4][2];
#pragma unroll
    for (int a = 0; a < 2; ++a)
#pragma unroll
        for (int b = 0; b < 2; ++b)
#pragma unroll
            for (int m = 0; m < 4; ++m)
#pragma unroll
                for (int n = 0; n < 2; ++n) acc[a][b][m][n] = (f32x4){0.f, 0.f, 0.f, 0.f};
    bf16x8 At[4][2], B0[2][2], B1[2][2];
    const char* cA = (const char*)g.A + (size_t)cur.pm * tstep; const char* cB = (const char*)g.Bt + (size_t)cur.pn * tstep;
    S.a_ready(cur);
    PG8_STAGE(PG8_SB(0, 0), cB, voffB); PG8_STAGE(PG8_SA(0, 0), cA, voffA); PG8_STAGE(PG8_SB(0, 1), cB + hstep, voffB); PG8_STAGE(PG8_SA(0, 1), cA + hstep, voffA);
    if (wr == 1) PG8_BAR;
    PG8_WAIT_V(4); PG8_BAR;
    PG8_STAGE(PG8_SB(1, 0), cB + kstep, voffB); PG8_STAGE(PG8_SA(1, 0), cA + kstep, voffA); PG8_STAGE(PG8_SB(1, 1), cB + hstep + kstep, voffB);
    PG8_WAIT_V(6); PG8_BAR;
    PG8_STAMP();
    for (;;) {
        const bool has_next = S.next(ui + 1, nxt);
        const char* nA = has_next ? (const char*)g.A + (size_t)nxt.pm * tstep : cA; const char* nB = has_next ? (const char*)g.Bt + (size_t)nxt.pn * tstep : cB;
        for (int t = 0; t < nt; t += 2) {
            const bool last = (t == nt - 2);
            const char* a1 = cA + (size_t)(t + 1) * kstep;
            const char* a2 = last ? nA : cA + (size_t)(t + 2) * kstep; const char* b2 = last ? nB : cB + (size_t)(t + 2) * kstep;
            const char* a3 = a2 + kstep; const char* b3 = b2 + kstep;
            if (last && has_next) S.a_ready(nxt);
            PG8_LDB(B0, 0, 0); PG8_SCHED; PG8_LDA(At, 0, 0); PG8_STAGE(PG8_SA(1, 1), a1 + hstep, voffA);
            PG8_WAIT_L(8); PG8_BAR; PG8_WAIT_L(0); PG8_MMA(0, 0, At, B0); PG8_BAR; PG8_SCHED;
            PG8_LDB(B1, 0, 1); PG8_STAGE(PG8_SB(0, 0), b2, voffB);
            PG8_BAR; PG8_WAIT_L(0); PG8_MMA(0, 1, At, B1); PG8_BAR;
            PG8_LDA(At, 0, 1); PG8_STAGE(PG8_SA(0, 0), a2, voffA);
            PG8_BAR; PG8_WAIT_L(0); PG8_MMA(1, 0, At, B0); PG8_BAR; PG8_SCHED;
            PG8_STAGE(PG8_SB(0, 1), b2 + hstep, voffB);
            PG8_WAIT_V(6); PG8_BAR; PG8_MMA(1, 1, At, B1); PG8_BAR;
            PG8_LDB(B0, 1, 0); PG8_SCHED; PG8_LDA(At, 1, 0); PG8_STAGE(PG8_SA(0, 1), a2 + hstep, voffA);
            PG8_WAIT_L(8); PG8_BAR; PG8_WAIT_L(0); PG8_MMA(0, 0, At, B0); PG8_BAR; PG8_SCHED;
            PG8_LDB(B1, 1, 1); PG8_STAGE(PG8_SB(1, 0), b3, voffB);
            PG8_BAR; PG8_WAIT_L(0); PG8_MMA(0, 1, At, B1); PG8_BAR;
            PG8_LDA(At, 1, 1); PG8_STAGE(PG8_SA(1, 0), a3, voffA);
            PG8_BAR; PG8_WAIT_L(0); PG8_MMA(1, 0, At, B0); PG8_BAR; PG8_SCHED;
            PG8_STAGE(PG8_SB(1, 1), b3 + hstep, voffB);
            PG8_WAIT_V(6); PG8_BAR; PG8_MMA(1, 1, At, B1); PG8_BAR;
        }
        PG8_STAMP();
        if constexpr (!Epi::AFTER_DRAIN) { E(acc, cur, wr, wc, fr, fq); S.done(cur); }
        PG8_STAMP();
        if (!has_next) break;
#pragma unroll
        for (int a = 0; a < 2; ++a)
#pragma unroll
            for (int b = 0; b < 2; ++b)
#pragma unroll
                for (int m = 0; m < 4; ++m)
#pragma unroll
                    for (int n = 0; n < 2; ++n) acc[a][b][m][n] = (f32x4){0.f, 0.f, 0.f, 0.f};
        cur = nxt; cA = nA; cB = nB; ++ui;
    }
    PG8_WAIT_V(0);
    if (wr == 0) PG8_BAR;
    PG8_BAR;
    if constexpr (Epi::AFTER_DRAIN) { E.fused(acc, cur, wr, wc, fr, fq, lds, wid, lane); S.done(cur); }
    PG8_STAMP();
    if (STAMP && wid == 0) { stamps[lane] = lane < nts ? (((unsigned long long)(unsigned)ts_hi << 32) | (unsigned)ts_lo) : 0ull;
        if (lane == 62) stamps[62] = rt_entry; if (lane == 63) stamps[63] = (unsigned long long)wall_clock64(); }
#undef PG8_STAMP
#undef PG8_SA
#undef PG8_SB
#undef PG8_STAGE
#undef PG8_LDA
#undef PG8_LDB
#undef PG8_MMA
#undef PG8_WAIT_V
#undef PG8_WAIT_L
#undef PG8_BAR
#undef PG8_SCHED
}
}

using pg8::bf16_t; using pg8::bf16x8; using pg8::f32x4; using pg8::u32x4;
typedef unsigned u32x2 __attribute__((ext_vector_type(2)));
#define LAS __attribute__((address_space(3)))
#define DI __device__ __forceinline__
#define MFMA16(a, b, c) __builtin_amdgcn_mfma_f32_16x16x32_bf16((a), (b), (c), 0, 0, 0)

constexpr int T_TOK = 8192, DM = 2048, SEQ = 2048, DEPTH = 4;
constexpr int DIN_SRC = 7176, DINP = 7424, ZLD = 7168, DFF = 5632, DFF2 = 11264;
constexpr int LDS_BYTES = 147456;
constexpr float EPS = 1e-6f;

constexpr size_t al256(size_t x) { return (x + 255) & ~(size_t)255; }
constexpr size_t SZ_WIN = (size_t)DINP * DM * 2, SZ_WOUT = (size_t)DM * DM * 2, SZ_WUP = (size_t)DFF2 * DM * 2, SZ_WD = (size_t)DM * DFF * 2;
constexpr size_t O_WIN = 0;
constexpr size_t O_WOUT = O_WIN + 4 * SZ_WIN;
constexpr size_t O_WUP = O_WOUT + 4 * SZ_WOUT;
constexpr size_t O_WD = O_WUP + 4 * SZ_WUP;
constexpr size_t O_XB = O_WD + 4 * SZ_WD;
constexpr size_t O_Z = O_XB + (size_t)T_TOK * DM * 2;
constexpr size_t O_GATES = O_Z + (size_t)T_TOK * ZLD * 2;
constexpr size_t O_QC = O_GATES + (size_t)T_TOK * 8 * 4;
constexpr size_t O_KC = O_QC + (size_t)T_TOK * 1024 * 2;
constexpr size_t O_KT = O_KC + (size_t)T_TOK * 1024 * 2;
constexpr size_t O_VT = O_KT + (size_t)T_TOK * 1024 * 2;
constexpr size_t O_GSC = O_VT + (size_t)T_TOK * 1024 * 2;
constexpr size_t O_ACH = O_GSC + (size_t)5 * 16 * 2048 * 4;
constexpr size_t O_AQN = O_ACH + 4096;
constexpr size_t O_AKN = O_AQN + (size_t)T_TOK * 1024 * 2;
constexpr size_t O_AVT = O_AKN + (size_t)T_TOK * 1024 * 2;
constexpr size_t O_KMEAN = O_AVT + (size_t)T_TOK * 1024 * 2;
constexpr size_t O_HBUF = O_KMEAN + (size_t)32 * 8 * 128 * 4;
constexpr size_t O_HSS = O_HBUF + (size_t)T_TOK * 1024 * 4;
constexpr size_t O_MIX = O_HSS + (size_t)T_TOK * 4 * 8;
constexpr size_t O_U = O_MIX + (size_t)T_TOK * DM * 2;
constexpr size_t O_ACT = O_U + (size_t)T_TOK * DFF2 * 2;
constexpr size_t O_SS = O_ACT + (size_t)T_TOK * DFF * 2;
constexpr size_t O_BIAST = O_SS + (size_t)9 * T_TOK * 8;
constexpr size_t O_TS = O_BIAST + (size_t)8 * 2048 * 4;
constexpr size_t O_CS = O_TS + 4096;
constexpr size_t O_NS = O_CS + (size_t)256 * 32 * 4096 * 2;
constexpr size_t O_BAR = O_NS + (size_t)16 * 32 * 256 * 4;
constexpr size_t WS_END = O_BAR + 16384;

struct Args {
    const float* x; const float* norm_mix; const float* w_in; const float* gate_bias; const float* conv_qk_w; const float* conv_qk_b;
    const float* mlstm_norm; const float* qk_norm; const float* rel_bias; const float* w_out; const float* norm_ffn; const float* w_up;
    const float* conv_ffn_w; const float* conv_ffn_b; const float* w_down;
    float* out; unsigned char* ws;
    int wv; int pad_;
};

DI unsigned f2bf(float f) { unsigned u = __builtin_bit_cast(unsigned, f); return (u + 0x7fffu + ((u >> 16) & 1u)) >> 16; }
typedef __bf16 bf16v2_t __attribute__((ext_vector_type(2)));
typedef float f32x2_t __attribute__((ext_vector_type(2)));
DI unsigned pk2(float lo, float hi) { f32x2_t v = {lo, hi}; return __builtin_bit_cast(unsigned, __builtin_convertvector(v, bf16v2_t)); }
DI float bflo(unsigned w) { return __builtin_bit_cast(float, w << 16); }
DI float bfhi(unsigned w) { return __builtin_bit_cast(float, w & 0xffff0000u); }
DI float bf1(bf16_t b) { return __builtin_bit_cast(float, ((unsigned)b) << 16); }
DI void unpack8(const u32x4 v, float (&f)[8]) { f[0] = bflo(v.x); f[1] = bfhi(v.x); f[2] = bflo(v.y); f[3] = bfhi(v.y); f[4] = bflo(v.z); f[5] = bfhi(v.z); f[6] = bflo(v.w); f[7] = bfhi(v.w); }
DI u32x4 pack8(const float (&f)[8]) { u32x4 r; r.x = pk2(f[0], f[1]); r.y = pk2(f[2], f[3]); r.z = pk2(f[4], f[5]); r.w = pk2(f[6], f[7]); return r; }
typedef unsigned long long u64;
constexpr float SS_SCALE = 268435456.0f, SS_INV = 1.0f / 268435456.0f;
constexpr float HS_SCALE = 4294967296.0f, HS_INV = 1.0f / 4294967296.0f;
DI u64 to_fix(float v, float scale) { return (u64)(v * scale + 0.5f); }
DI void bar_lds() { asm volatile("s_waitcnt lgkmcnt(0)" ::: "memory"); __builtin_amdgcn_s_barrier(); asm volatile("" ::: "memory"); }
DI float sigmoidf_(float x) { return __builtin_amdgcn_rcpf(1.0f + __builtin_amdgcn_exp2f(x * -1.4426950408889634f)); }
DI float siluf_(float x) { return x * __builtin_amdgcn_rcpf(1.0f + __builtin_amdgcn_exp2f(x * -1.4426950408889634f)); }

struct EpiScale {
    static constexpr bool PERM = true, AFTER_DRAIN = false;
    bf16_t* O; int ldc; const u64* SS; float* gates; int gate_pn;
    DI void operator()(const f32x4 (&acc)[2][2][4][2], const pg8::Unit& u, int wr, int wc, int fr, int fq) const {
        const int row0 = u.pm * 256 + wr * 64 + fr, col0 = u.pn * 256 + wc * 32 + 8 * fq;
#pragma unroll
        for (int ai = 0; ai < 2; ++ai)
#pragma unroll
            for (int m = 0; m < 4; ++m) {
                const int r = row0 + ai * 128 + m * 16;
                const float rstd = rsqrtf((float)SS[r] * (SS_INV / 2048.0f) + EPS);
                if (u.pn == gate_pn) {
                    if (wc == 0 && fq == 0) { *(f32x4*)(gates + (size_t)r * 8) = acc[ai][0][m][0] * rstd; *(f32x4*)(gates + (size_t)r * 8 + 4) = acc[ai][0][m][1] * rstd; }
                } else {
                    bf16_t* rowp = O + (size_t)r * ldc + col0;
#pragma unroll
                    for (int bj = 0; bj < 2; ++bj) { const f32x4 v0 = acc[ai][bj][m][0] * rstd, v1 = acc[ai][bj][m][1] * rstd;
                        u32x4 w; w.x = pk2(v0[0], v0[1]); w.y = pk2(v0[2], v0[3]); w.z = pk2(v1[0], v1[1]); w.w = pk2(v1[2], v1[3]);
                        *(u32x4*)(rowp + bj * 128) = w; }
                }
            }
    }
};
struct EpiRes {
    static constexpr bool PERM = false, AFTER_DRAIN = false;
    float* X; bf16_t* XB; u64* SS;
    DI void operator()(const f32x4 (&acc)[2][2][4][2], const pg8::Unit& u, int wr, int wc, int fr, int fq) const {
        const int row0 = u.pm * 256 + wr * 64 + fr, col0 = u.pn * 256 + wc * 32 + 4 * fq;
#pragma unroll
        for (int ai = 0; ai < 2; ++ai)
#pragma unroll
            for (int m = 0; m < 4; ++m) {
                const int r = row0 + ai * 128 + m * 16;
                bf16_t* bp = XB + (size_t)r * DM + col0; float ssq = 0.f;
                u32x2 old[2][2];
#pragma unroll
                for (int bj = 0; bj < 2; ++bj)
#pragma unroll
                    for (int n = 0; n < 2; ++n) old[bj][n] = *(const u32x2*)(bp + bj * 128 + n * 16);
#pragma unroll
                for (int bj = 0; bj < 2; ++bj)
#pragma unroll
                    for (int n = 0; n < 2; ++n) { f32x4 v = acc[ai][bj][m][n];
                        v[0] += bflo(old[bj][n].x); v[1] += bfhi(old[bj][n].x); v[2] += bflo(old[bj][n].y); v[3] += bfhi(old[bj][n].y);
                        ssq += v[0] * v[0] + v[1] * v[1] + v[2] * v[2] + v[3] * v[3];
                        u32x2 p; p.x = pk2(v[0], v[1]); p.y = pk2(v[2], v[3]); *(u32x2*)(bp + bj * 128 + n * 16) = p;
                        if (X) __builtin_nontemporal_store(v, (f32x4*)(X + (size_t)r * DM + col0 + bj * 128 + n * 16)); }
                ssq += shx(ssq, 16); ssq += shx(ssq, 32);
                if (fq == 0) atomicAdd(SS + r, to_fix(ssq, SS_SCALE));
            }
    }
};

template <class Epi> DI void run_gemm(unsigned char* smem, const bf16_t* A, const bf16_t* Bt, int M, int N, int K, const Epi& E, int wv) {
    pg8::Gemm g; g.A = A; g.Bt = Bt; g.M = M; g.N = N; g.K = K; g.wv = wv;
    pg8::StaticOrder S; S.init(M, N, (int)gridDim.x, (int)blockIdx.x);
    pg8::gemm_phase<Epi, pg8::StaticOrder, false>((PG8_LAS unsigned char*)smem, g, S, E, nullptr);
}

struct TG { const float* src; const float* g; bf16_t* dst; int ldsrc, sc, nv, k0, ldd, n0; };
DI TG decode_tg(const Args& a, int it) {
    constexpr int PER_LAYER = 29 * 32 + 8 * 32 + 44 * 32 + 8 * 88;
    const int l = it / PER_LAYER; int r = it % PER_LAYER; TG t;
    if (r < 29 * 32) { const int kt = r / 29, gi = r % 29;
        if (gi < 16) { t.sc = gi * 256; t.nv = 256; } else if (gi < 28) { t.sc = gi * 256 + 8; t.nv = 256; } else { t.sc = 4096; t.nv = 8; }
        t.src = a.w_in + (size_t)l * DM * DIN_SRC; t.ldsrc = DIN_SRC; t.k0 = kt * 64; t.g = a.norm_mix + l * DM; t.dst = (bf16_t*)(a.ws + O_WIN + l * SZ_WIN); t.ldd = DM; t.n0 = gi * 256;
    } else if ((r -= 29 * 32) < 8 * 32) { const int kt = r / 8, gi = r % 8;
        t.src = a.w_out + (size_t)l * DM * DM; t.ldsrc = DM; t.sc = gi * 256; t.nv = 256; t.k0 = kt * 64; t.g = nullptr; t.dst = (bf16_t*)(a.ws + O_WOUT + l * SZ_WOUT); t.ldd = DM; t.n0 = gi * 256;
    } else if ((r -= 8 * 32) < 44 * 32) { const int kt = r / 44, gi = r % 44;
        t.src = a.w_up + (size_t)l * DM * DFF2; t.ldsrc = DFF2; t.sc = gi * 256; t.nv = 256; t.k0 = kt * 64; t.g = a.norm_ffn + l * DM; t.dst = (bf16_t*)(a.ws + O_WUP + l * SZ_WUP); t.ldd = DM; t.n0 = gi * 256;
    } else { r -= 44 * 32; const int kt = r / 8, gi = r % 8;
        t.src = a.w_down + (size_t)l * DFF * DM; t.ldsrc = DM; t.sc = gi * 256; t.nv = 256; t.k0 = kt * 64; t.g = nullptr; t.dst = (bf16_t*)(a.ws + O_WD + l * SZ_WD); t.ldd = DFF; t.n0 = gi * 256; }
    return t;
}
DI void tg_load(const TG& t, int tid, f32x4 (&v)[8], float (&gv)[8]) {
    const int c4 = (tid & 63) * 4, kr = tid >> 6;
#pragma unroll
    for (int i = 0; i < 8; ++i) { v[i] = (f32x4){0.f, 0.f, 0.f, 0.f}; if (c4 < t.nv) v[i] = __builtin_nontemporal_load((const f32x4*)(t.src + (size_t)(t.k0 + kr + 8 * i) * t.ldsrc + t.sc + c4));
        gv[i] = t.g ? t.g[t.k0 + kr + 8 * i] : 1.0f; }
}

DI int t5_bucket(int d) {
    if (d < 16) return d;
    const float ratio = (float)d / 16.0f;
    int large = 16 + (int)(logf(ratio) / 4.852030263919617f * 16.0f);
    return large < 31 ? large : 31;
}

DI void phase0(const Args& a, unsigned char* smem) {
    float* tile = (float*)smem;
    const int tid = otid();
    constexpr int PER_LAYER = 29 * 32 + 8 * 32 + 44 * 32 + 8 * 88;
    constexpr int NTILES = 4 * PER_LAYER, NX = 1024;
    {
        f32x4 v[8]; float gv[8]; TG cur, nx;
        int it = blockIdx.x;
        if (it < NTILES) { cur = decode_tg(a, NTILES - 1 - it); tg_load(cur, tid, v, gv); }
#pragma unroll 1
        for (; it < NTILES; it += gridDim.x) {
            { const int c4 = (tid & 63) * 4, kr = tid >> 6;
#pragma unroll
              for (int i = 0; i < 8; ++i) { const f32x4 vv = v[i] * gv[i]; float* tp = tile + (kr + 8 * i) * 260 + c4; *(f32x4*)tp = vv; } }
            const int nxt = it + gridDim.x;
            nx = cur;
            if (nxt < NTILES) { nx = decode_tg(a, NTILES - 1 - nxt); tg_load(nx, tid, v, gv); }
            bar_lds();
            { const int n = tid >> 1, kh = (tid & 1) * 32; const bool late = (NTILES - 1 - it) >= 2 * PER_LAYER;
#pragma unroll
              for (int q = 0; q < 4; ++q) { float f[8];
#pragma unroll
                  for (int j = 0; j < 8; ++j) f[j] = tile[(kh + q * 8 + j) * 260 + n];
                  u32x4* dp = (u32x4*)(cur.dst + (size_t)(cur.n0 + n) * cur.ldd + cur.k0 + kh + q * 8);
                  if (late) __builtin_nontemporal_store(pack8(f), dp); else *dp = pack8(f); } }
            bar_lds();
            cur = nx;
        }
    }
    for (int it = blockIdx.x; it < NX; it += gridDim.x) {
        {
            const int row = it * 8 + (tid >> 6), lane = tid & 63;
            const float* xp = a.x + (size_t)row * DM; bf16_t* bp = (bf16_t*)(a.ws + O_XB) + (size_t)row * DM;
            float ssq = 0.f;
#pragma unroll
            for (int i = 0; i < 8; ++i) { const int c = (i * 64 + lane) * 4; const f32x4 v = *(const f32x4*)(xp + c);
                ssq += v[0] * v[0] + v[1] * v[1] + v[2] * v[2] + v[3] * v[3]; u32x2 p; p.x = pk2(v[0], v[1]); p.y = pk2(v[2], v[3]); *(u32x2*)(bp + c) = p; }
#pragma unroll
            for (int o = 1; o < 64; o <<= 1) ssq += shx(ssq, o);
            if (lane == 0) ((u64*)(a.ws + O_SS))[row] = to_fix(ssq, SS_SCALE);
        }
    }
    const int gt = blockIdx.x * 512 + tid, gn = gridDim.x * 512;
    u64* ss = (u64*)(a.ws + O_SS);
    { const u64 z0 = (u64)((unsigned)tid >> 31); for (int i = gt; i < 8 * T_TOK; i += gn) ss[T_TOK + i] = z0; }
    float* bt = (float*)(a.ws + O_BIAST);
    for (int i = gt; i < 8 * 2048; i += gn) { const int h = i >> 11, d = i & 2047; bt[i] = a.rel_bias[t5_bucket(d) * 8 + h] * 1.4426950408889634f; }
}

DI void prep_mlstm_item(const Args& a, int l, int item, unsigned char* smem) {
    const int bh = item >> 5, c = item & 31, b = bh >> 2, h = bh & 3, tid = otid();
    const bf16_t* z = (const bf16_t*)(a.ws + O_Z);
    bf16_t* tileK = (bf16_t*)smem; bf16_t* tileV = (bf16_t*)(smem + 64 * 264 * 2);
    const int cg8 = tid & 31, rg = tid >> 5;
    const size_t trow0 = (size_t)b * SEQ + c * 64;
    u32x4 zr[2][7], vr[4]; f32x4 wv[2][4][2], bv[2][2];
#pragma unroll
    for (int part = 0; part < 2; ++part) { const int ch0 = part * 1024 + h * 256 + cg8 * 8;
#pragma unroll
        for (int i = 0; i < 7; ++i) { const int sl = c * 64 + rg * 4 - 3 + i; zr[part][i] = (u32x4){0u, 0u, 0u, 0u}; if (sl >= 0) zr[part][i] = __builtin_nontemporal_load((const u32x4*)(z + ((size_t)b * SEQ + sl) * ZLD + ch0)); } }
    { const int row = tid >> 3, seg = tid & 7;
#pragma unroll
      for (int i = 0; i < 4; ++i) vr[i] = __builtin_nontemporal_load((const u32x4*)(z + (trow0 + row) * ZLD + 2048 + h * 256 + seg * 8 + i * 64)); }
#pragma unroll
    for (int part = 0; part < 2; ++part) { const int ch0 = part * 1024 + h * 256 + cg8 * 8;
        const float* cw = a.conv_qk_w + (size_t)l * 4 * 2048 + ch0; const float* cb = a.conv_qk_b + (size_t)l * 2048 + ch0;
#pragma unroll
        for (int j = 0; j < 4; ++j) { wv[part][j][0] = *(const f32x4*)(cw + j * 2048); wv[part][j][1] = *(const f32x4*)(cw + j * 2048 + 4); }
        bv[part][0] = *(const f32x4*)cb; bv[part][1] = *(const f32x4*)(cb + 4); }
    __syncthreads();
    { const int row = tid >> 3, seg = tid & 7;
#pragma unroll
      for (int i = 0; i < 4; ++i) *(u32x4*)(tileV + row * 264 + seg * 8 + i * 64) = vr[i]; }
#pragma unroll
    for (int part = 0; part < 2; ++part) {
        float xin[7][8];
#pragma unroll
        for (int i = 0; i < 7; ++i) unpack8(zr[part][i], xin[i]);
        bf16_t* dst = (bf16_t*)(a.ws + (part == 0 ? O_QC : O_KC));
        const float osc = part == 0 ? 0.0625f : 1.0f;
#pragma unroll
        for (int o = 0; o < 4; ++o) { float y[8];
#pragma unroll
            for (int e = 0; e < 8; ++e) { float s_ = bv[part][e >> 2][e & 3];
#pragma unroll
                for (int j = 0; j < 4; ++j) s_ += wv[part][j][e >> 2][e & 3] * xin[o + j][e];
                y[e] = siluf_(s_) * osc; }
            const u32x4 pk = pack8(y);
            *(u32x4*)(dst + (trow0 + rg * 4 + o) * 1024 + h * 256 + cg8 * 8) = pk;
            if (part == 1) *(u32x4*)(tileK + (rg * 4 + o) * 264 + cg8 * 8) = pk; }
    }
    bar_lds();
    { const int d = tid >> 1, sh = tid & 1;
      bf16_t* kT = (bf16_t*)(a.ws + O_KT) + ((size_t)(bh * 32 + c) * 256 + d) * 64 + sh * 32;
      bf16_t* vT = (bf16_t*)(a.ws + O_VT) + ((size_t)(bh * 32 + c) * 256 + d) * 64 + sh * 32;
#pragma unroll
      for (int i = 0; i < 4; ++i) { unsigned w1[4], w2[4];
#pragma unroll
          for (int j = 0; j < 4; ++j) { const int s_ = sh * 32 + i * 8 + j * 2;
              w1[j] = (unsigned)tileK[s_ * 264 + d] | ((unsigned)tileK[(s_ + 1) * 264 + d] << 16);
              w2[j] = (unsigned)tileV[s_ * 264 + d] | ((unsigned)tileV[(s_ + 1) * 264 + d] << 16); }
          u32x4 v1, v2; v1.x = w1[0]; v1.y = w1[1]; v1.z = w1[2]; v1.w = w1[3]; v2.x = w2[0]; v2.y = w2[1]; v2.z = w2[2]; v2.w = w2[3];
          *(u32x4*)(kT + i * 8) = v1; *(u32x4*)(vT + i * 8) = v2; } }
    bar_lds();
}

DI void prep_attn_item(const Args& a, int l, int item, unsigned char* smem) {
    const int b = item >> 6, blk = (item >> 3) & 7, head = item & 7, tid = otid();
    const bf16_t* z = (const bf16_t*)(a.ws + O_Z);
    bf16_t* tile = (bf16_t*)smem;
    float* part = (float*)(smem + 256 * 136 * 2);
    const int lr = tid >> 4, cgp = tid & 15;
    const size_t t0 = (size_t)b * SEQ + blk * 256;
    float g0[8], g1[8], colsum[8];
    { const float* gp = a.qk_norm + (size_t)l * 256 + cgp * 8;
#pragma unroll
      for (int e = 0; e < 8; ++e) { g0[e] = gp[e] * (0.08838834764831845f * 1.4426950408889634f); g1[e] = gp[128 + e]; colsum[e] = 0.f; } }
    bf16_t* aqn = (bf16_t*)(a.ws + O_AQN); bf16_t* akn = (bf16_t*)(a.ws + O_AKN);
#pragma unroll 1
    for (int pb = 0; pb < 2; ++pb) {
        u32x4 rq[4], rk[4], rv[4];
#pragma unroll
        for (int pp = 0; pp < 4; ++pp) { const int r = (pb * 4 + pp) * 32 + lr; const bf16_t* zr = z + (t0 + r) * ZLD + head * 128 + cgp * 8;
            rq[pp] = __builtin_nontemporal_load((const u32x4*)(zr + 4096)); rk[pp] = __builtin_nontemporal_load((const u32x4*)(zr + 5120)); rv[pp] = __builtin_nontemporal_load((const u32x4*)(zr + 6144)); }
#pragma unroll
        for (int pp = 0; pp < 4; ++pp) { const int r = (pb * 4 + pp) * 32 + lr;
            float f[8], y[8];
            { unpack8(rq[pp], f); float ssq = 0.f;
#pragma unroll
              for (int e = 0; e < 8; ++e) ssq += f[e] * f[e];
              ssq += shx(ssq, 1); ssq += shx(ssq, 2); ssq += shx(ssq, 4); ssq += shx(ssq, 8);
              const float rstd = rsqrtf(ssq * (1.0f / 128.0f) + EPS);
#pragma unroll
              for (int e = 0; e < 8; ++e) y[e] = f[e] * rstd * g0[e];
              *(u32x4*)(aqn + (t0 + r) * 1024 + head * 128 + cgp * 8) = pack8(y); }
            { unpack8(rk[pp], f); float ssq = 0.f;
#pragma unroll
              for (int e = 0; e < 8; ++e) ssq += f[e] * f[e];
              ssq += shx(ssq, 1); ssq += shx(ssq, 2); ssq += shx(ssq, 4); ssq += shx(ssq, 8);
              const float rstd = rsqrtf(ssq * (1.0f / 128.0f) + EPS);
#pragma unroll
              for (int e = 0; e < 8; ++e) { y[e] = f[e] * rstd * g1[e]; colsum[e] += y[e]; }
              *(u32x4*)(akn + (t0 + r) * 1024 + head * 128 + cgp * 8) = pack8(y); }
            *(u32x4*)(tile + r * 136 + cgp * 8) = rv[pp]; }
    }
#pragma unroll
    for (int e = 0; e < 8; ++e) part[lr * 128 + cgp * 8 + e] = colsum[e];
    __syncthreads();
    if (tid < 128) { float s = 0.f;
#pragma unroll 8
        for (int i = 0; i < 32; ++i) s += part[i * 128 + tid];
        ((float*)(a.ws + O_KMEAN))[((size_t)(b * 8 + head) * 8 + blk) * 128 + tid] = s * (1.0f / 256.0f); }
    { const int d = tid >> 2, seg = tid & 3; bf16_t* vT = (bf16_t*)(a.ws + O_AVT) + ((size_t)(b * 8 + head) * 128 + d) * SEQ + blk * 256 + seg * 64;
#pragma unroll
      for (int i = 0; i < 8; ++i) { unsigned wv[4];
#pragma unroll
          for (int j = 0; j < 4; ++j) { const int r = seg * 64 + i * 8 + j * 2; wv[j] = (unsigned)tile[r * 136 + d] | ((unsigned)tile[(r + 1) * 136 + d] << 16); }
          u32x4 v; v.x = wv[0]; v.y = wv[1]; v.z = wv[2]; v.w = wv[3]; *(u32x4*)(vT + i * 8) = v; } }
    __syncthreads();
}

DI void prep_gate_item(const Args& a, int l, int bh, unsigned char* smem) {
    const int tid = otid(), w = tid >> 6, lane = tid & 63, b = bh >> 2, h = bh & 3;
    float* gl = (float*)smem;
    const float* gates = (const float*)(a.ws + O_GATES); float* gsc = (float*)(a.ws + O_GSC); float* ach = (float*)(a.ws + O_ACH);
    const float bi = a.gate_bias[l * 8 + h], bf = a.gate_bias[l * 8 + 4 + h];
    float u_[4], bs_[4], cm_[4];
#pragma unroll
    for (int i = 0; i < 4; ++i) { const int c = w * 4 + i; const size_t t = (size_t)b * SEQ + c * 64 + lane;
        const float li = gates[t * 8 + h] + bi, xf = gates[t * 8 + 4 + h] + bf;
        const float lf = fminf(xf, 0.f) - log1pf(expf(-fabsf(xf)));
        float bs = lf;
#pragma unroll
        for (int o = 1; o < 64; o <<= 1) { const float v = shu(bs, o); if (lane >= o) bs += v; }
        const float u = li - bs; float cm = u;
#pragma unroll
        for (int o = 1; o < 64; o <<= 1) { const float v = shu(cm, o); if (lane >= o) cm = fmaxf(cm, v); }
        u_[i] = u; bs_[i] = bs; cm_[i] = cm;
        if (lane == 63) { gl[c] = bs; gl[32 + c] = cm; } }
    __syncthreads();
    if (tid == 0) { float m = 0.f;
#pragma unroll 1
        for (int c = 0; c < 32; ++c) { gl[64 + c] = m; m = gl[c] + fmaxf(m, gl[32 + c]); } }
    __syncthreads();
#pragma unroll
    for (int i = 0; i < 4; ++i) { const int c = w * 4 + i; const float m = gl[64 + c];
        const float M = fmaxf(m, cm_[i]), W = expf(m - M), F = expf(-(bs_[i] + M)), M63 = fmaxf(m, gl[32 + c]);
        const size_t o = (size_t)bh * SEQ + c * 64 + lane;
        gsc[o] = u_[i]; gsc[32768 + o] = M; gsc[65536 + o] = W; gsc[98304 + o] = F; gsc[131072 + o] = expf(u_[i] - M63);
        if (lane == 0) ach[bh * 32 + c] = expf(m - M63); }
    __syncthreads();
}

DI void phase_prep(const Args& a, int l, unsigned char* smem) {
    for (int it = blockIdx.x; it < 512 + 256 + 16; it += gridDim.x) {
        if (it < 512) { const int i = it & 255, xcd = i & 7, slot = i >> 3, bh = xcd * 2 + (slot >> 4), c = (slot & 15) + 16 * (it >> 8); prep_mlstm_item(a, l, bh * 32 + c, smem); }
        else if (it < 768) { const int i = it - 512, xcd = i & 7, slot = i >> 3, bh = xcd * 4 + (slot >> 3), blk = slot & 7; prep_attn_item(a, l, (bh >> 3) * 64 + blk * 8 + (bh & 7), smem); }
        else { const int i = it - 768; prep_gate_item(a, l, (i & 7) * 2 + (i >> 3), smem); }
    }
}

DI void mlstm_item(const Args& a, int item, unsigned char* smem) {
    const int bh = item >> 4, es = item & 15, b = bh >> 2, h = bh & 3, e0 = es * 16;
    const int tid = otid(), w = tid >> 6, lane = tid & 63, fr = lane & 15, fq = lane >> 4;
    float* nst = (float*)smem;
    float* gU = (float*)(smem + 32768); float* gM = gU + 2048; float* gW = gM + 2048; float* gF = gW + 2048; float* gWK = gF + 2048; float* adecs = gWK + 2048;
    const bf16_t* qc = (const bf16_t*)(a.ws + O_QC); const bf16_t* kc = (const bf16_t*)(a.ws + O_KC);
    const bf16_t* kT = (const bf16_t*)(a.ws + O_KT); const bf16_t* vT = (const bf16_t*)(a.ws + O_VT);
    const float* gsc = (const float*)(a.ws + O_GSC); const float* ach = (const float*)(a.ws + O_ACH);
    float* NS = (float*)(a.ws + O_NS);
    bf16_t* CS = (bf16_t*)(a.ws + O_CS) + (size_t)item * 32 * 4096;
    __syncthreads();
    for (int i = tid; i < 2048; i += 512) { const size_t o = (size_t)bh * SEQ + i; gWK[i] = gsc[131072 + o]; }
    if (tid < 32) adecs[tid] = ach[bh * 32 + tid];
    __syncthreads();
    {
        f32x4 accC[2]; accC[0] = (f32x4){0.f, 0.f, 0.f, 0.f}; accC[1] = accC[0]; float nacc[2] = {0.f, 0.f};
        const bf16_t* ktp = kT + ((size_t)(bh * 32) * 256 + (2 * w) * 16 + fr) * 64 + fq * 8;
        const bf16_t* vtp = vT + ((size_t)(bh * 32) * 256 + e0 + fr) * 64 + fq * 8;
        bf16x8 rk[4][4], rv[4][2];
#define LA_LOAD(set, cc) do { _Pragma("unroll") for (int i_ = 0; i_ < 2; ++i_) _Pragma("unroll") for (int k_ = 0; k_ < 2; ++k_) rk[set][i_ * 2 + k_] = *(const bf16x8*)(ktp + (size_t)(cc) * 16384 + i_ * 1024 + k_ * 32); \
        _Pragma("unroll") for (int k_ = 0; k_ < 2; ++k_) rv[set][k_] = *(const bf16x8*)(vtp + (size_t)(cc) * 16384 + k_ * 32); } while (0)
        LA_LOAD(0, 0); LA_LOAD(1, 1); LA_LOAD(2, 2); LA_LOAD(3, 3);
#pragma unroll
        for (int c0 = 0; c0 < 32; c0 += 4) {
#pragma unroll
            for (int j = 0; j < 4; ++j) { const int c = c0 + j;
                if (c < 31) {
                    const float adec = adecs[c];
                    bf16x8 vw[2]; float wk[2][8];
#pragma unroll
                    for (int kk = 0; kk < 2; ++kk) { const f32x4 w0 = *(const f32x4*)(gWK + c * 64 + kk * 32 + fq * 8), w1 = *(const f32x4*)(gWK + c * 64 + kk * 32 + fq * 8 + 4);
                        wk[kk][0] = w0[0]; wk[kk][1] = w0[1]; wk[kk][2] = w0[2]; wk[kk][3] = w0[3]; wk[kk][4] = w1[0]; wk[kk][5] = w1[1]; wk[kk][6] = w1[2]; wk[kk][7] = w1[3];
                        float f[8]; unpack8(__builtin_bit_cast(u32x4, rv[j][kk]), f);
#pragma unroll
                        for (int e = 0; e < 8; ++e) f[e] *= wk[kk][e];
                        vw[kk] = __builtin_bit_cast(bf16x8, pack8(f)); }
#pragma unroll
                    for (int i = 0; i < 2; ++i) { f32x4 acc = accC[i] * adec;
#pragma unroll
                        for (int kk = 0; kk < 2; ++kk) acc = MFMA16(rk[j][i * 2 + kk], vw[kk], acc);
                        accC[i] = acc;
                        u32x2 pw; pw.x = pk2(acc[0], acc[1]); pw.y = pk2(acc[2], acc[3]);
                        *(u32x2*)(CS + (size_t)(c + 1) * 4096 + fr * 256 + (2 * w + i) * 16 + 4 * fq) = pw;
                        if (2 * w + i == es) {
                            float ns = 0.f;
#pragma unroll
                            for (int kk = 0; kk < 2; ++kk) { float f[8]; unpack8(__builtin_bit_cast(u32x4, rk[j][i * 2 + kk]), f);
#pragma unroll
                                for (int e = 0; e < 8; ++e) ns += f[e] * wk[kk][e]; }
                            ns += shx(ns, 16); ns += shx(ns, 32); nacc[i] = adec * nacc[i] + ns;
                            if (fq == 0) NS[(size_t)(bh * 32 + c + 1) * 256 + (2 * w + i) * 16 + fr] = nacc[i]; } }
                }
                if (c + 4 < 31) LA_LOAD(j, c + 4);
            }
        }
#undef LA_LOAD
    }
}

constexpr int MO_QS = 0, MO_KS = 34816, MO_PS = 69632, MO_RSP = 79872, MO_QN = 80896, MO_HSQ = 81152, MO_NL = 83200, MO_SCL = 84224;
DI void mlstm_out_item(const Args& a, int l, int item, unsigned char* smem) {
    const int bh = item >> 5, c = item & 31, b = bh >> 2, h = bh & 3;
    const int tid = otid(), w = tid >> 6, lane = tid & 63, fr = lane & 15, fq = lane >> 4;
    bf16_t* Qs = (bf16_t*)(smem + MO_QS); bf16_t* Ks = (bf16_t*)(smem + MO_KS); bf16_t* Ps = (bf16_t*)(smem + MO_PS);
    float* rsp = (float*)(smem + MO_RSP); float* qnv = (float*)(smem + MO_QN); float* hsq = (float*)(smem + MO_HSQ); float* nloc = (float*)(smem + MO_NL); float* scl = (float*)(smem + MO_SCL);
    const bf16_t* qc = (const bf16_t*)(a.ws + O_QC); const bf16_t* kc = (const bf16_t*)(a.ws + O_KC); const bf16_t* vT = (const bf16_t*)(a.ws + O_VT);
    const float* gsc = (const float*)(a.ws + O_GSC); const bf16_t* CS = (const bf16_t*)(a.ws + O_CS); const float* NS = (const float*)(a.ws + O_NS);
    const size_t tb = (size_t)b * SEQ + c * 64;
    __syncthreads();
    { const int qrow = tid >> 3, qseg = tid & 7; u32x4 pq[4], pk[4];
#pragma unroll
      for (int i = 0; i < 4; ++i) { pq[i] = *(const u32x4*)(qc + (tb + qrow) * 1024 + h * 256 + (qseg + 8 * i) * 8); pk[i] = *(const u32x4*)(kc + (tb + qrow) * 1024 + h * 256 + (qseg + 8 * i) * 8); }
      { const unsigned z0 = (unsigned)tid >> 31; u32x4 zz; zz.x = z0; zz.y = z0; zz.z = z0; zz.w = z0;
        for (int i = tid; i < 640; i += 512) ((u32x4*)Ps)[i] = zz; }
      if (tid < 256) nloc[tid] = (c > 0) ? NS[(size_t)(bh * 32 + c) * 256 + tid] : 0.f;
      else scl[tid - 256] = gsc[(size_t)((tid - 256) >> 6) * 32768 + (size_t)bh * SEQ + c * 64 + (tid & 63)];
#pragma unroll
      for (int i = 0; i < 4; ++i) { *(u32x4*)(Qs + qrow * 272 + (qseg + 8 * i) * 8) = pq[i]; *(u32x4*)(Ks + qrow * 272 + (qseg + 8 * i) * 8) = pk[i]; } }
    bf16x8 cf[2][8], vtf[2][2];
#pragma unroll
    for (int i = 0; i < 2; ++i) {
        const bf16_t* cp = CS + ((size_t)((bh * 16 + 2 * w + i) * 32 + c)) * 4096 + fr * 256 + fq * 8;
#pragma unroll
        for (int kk = 0; kk < 8; ++kk) cf[i][kk] = (c > 0) ? *(const bf16x8*)(cp + kk * 32) : (bf16x8){0, 0, 0, 0, 0, 0, 0, 0};
        const bf16_t* vp = vT + ((size_t)(bh * 32 + c) * 256 + 32 * w + 16 * i + fr) * 64 + fq * 8;
#pragma unroll
        for (int kk = 0; kk < 2; ++kk) vtf[i][kk] = *(const bf16x8*)(vp + kk * 32); }
    const bf16_t* z = (const bf16_t*)(a.ws + O_Z); bf16_t* mix = (bf16_t*)(a.ws + O_MIX); const float* gn = a.mlstm_norm + (size_t)l * 1024 + h * 256;
    u32x2 mo2[4][2]; f32x4 g4[2];
#pragma unroll
    for (int i = 0; i < 2; ++i) { const int e = 32 * w + 16 * i + 4 * fq; g4[i] = *(const f32x4*)(gn + e);
#pragma unroll
        for (int rt = 0; rt < 4; ++rt) mo2[rt][i] = *(const u32x2*)(z + (tb + rt * 16 + fr) * ZLD + 3072 + h * 256 + e); }
    bar_lds();
#pragma unroll 1
    for (int ti = w; ti < 10; ti += 8) {
        const int rt = ti < 1 ? 0 : ti < 3 ? 1 : ti < 6 ? 2 : 3, ct = ti - (rt * (rt + 1)) / 2;
        bf16x8 qf[8], kf[8];
#pragma unroll
        for (int kk = 0; kk < 8; ++kk) { qf[kk] = *(const bf16x8*)(Qs + (rt * 16 + fr) * 272 + kk * 32 + fq * 8); kf[kk] = *(const bf16x8*)(Ks + (ct * 16 + fr) * 272 + kk * 32 + fq * 8); }
        f32x4 sacc = {0.f, 0.f, 0.f, 0.f};
#pragma unroll
        for (int kk = 0; kk < 8; ++kk) sacc = MFMA16(kf[kk], qf[kk], sacc);
        const int t = rt * 16 + fr, s0 = ct * 16 + 4 * fq;
        const f32x4 us = *(const f32x4*)(scl + s0); const float Mt = scl[64 + t];
        float p[4], rs = 0.f;
#pragma unroll
        for (int j = 0; j < 4; ++j) { p[j] = (s0 + j <= t) ? sacc[j] * __expf(us[j] - Mt) : 0.f; rs += p[j]; }
        rs += shx(rs, 16); rs += shx(rs, 32);
        if (fq == 0) rsp[(rt * 4 + ct) * 16 + fr] = rs;
        u32x2 pw; pw.x = pk2(p[0], p[1]); pw.y = pk2(p[2], p[3]); *(u32x2*)(Ps + t * 80 + s0) = pw;
    }
    { const int t = tid >> 3, pr = tid & 7; float dsum = 0.f;
#pragma unroll
      for (int i = 0; i < 4; ++i) { float f[8]; unpack8(*(const u32x4*)(Qs + t * 272 + i * 64 + pr * 8), f);
          const f32x4 n0 = *(const f32x4*)(nloc + i * 64 + pr * 8), n1 = *(const f32x4*)(nloc + i * 64 + pr * 8 + 4);
          dsum += f[0] * n0[0] + f[1] * n0[1] + f[2] * n0[2] + f[3] * n0[3] + f[4] * n1[0] + f[5] * n1[1] + f[6] * n1[2] + f[7] * n1[3]; }
      dsum += shx(dsum, 1); dsum += shx(dsum, 2); dsum += shx(dsum, 4);
      if (pr == 0) qnv[t] = dsum; }
    bar_lds();
    f32x4 hv[4][2];
#pragma unroll
    for (int rt = 0; rt < 4; ++rt) {
        bf16x8 qf[8], pf[2];
#pragma unroll
        for (int kk = 0; kk < 8; ++kk) qf[kk] = *(const bf16x8*)(Qs + (rt * 16 + fr) * 272 + kk * 32 + fq * 8);
#pragma unroll
        for (int kk = 0; kk < 2; ++kk) pf[kk] = *(const bf16x8*)(Ps + (rt * 16 + fr) * 80 + kk * 32 + fq * 8);
        const int t = rt * 16 + fr;
        const float Wt = scl[128 + t], Ft = scl[192 + t];
        float rowsum = 0.f;
#pragma unroll
        for (int ct = 0; ct < 4; ++ct) if (ct <= rt) rowsum += rsp[(rt * 4 + ct) * 16 + fr];
        const float den = Wt * qnv[t] + rowsum, inv = 1.0f / fmaxf(fabsf(den), Ft);
        float hs = 0.f;
#pragma unroll
        for (int i = 0; i < 2; ++i) { f32x4 a1 = {0.f, 0.f, 0.f, 0.f}, a2 = {0.f, 0.f, 0.f, 0.f};
#pragma unroll
            for (int kk = 0; kk < 8; ++kk) a1 = MFMA16(cf[i][kk], qf[kk], a1);
#pragma unroll
            for (int kk = 0; kk < 2; ++kk) a2 = MFMA16(vtf[i][kk], pf[kk], a2);
#pragma unroll
            for (int j = 0; j < 4; ++j) { const float v = (Wt * a1[j] + a2[j]) * inv; hv[rt][i][j] = v; hs += v * v; } }
        hs += shx(hs, 16); hs += shx(hs, 32);
        if (fq == 0) hsq[w * 64 + t] = hs;
    }
    bar_lds();
#pragma unroll
    for (int rt = 0; rt < 4; ++rt) {
        const int t = rt * 16 + fr; float tot = 0.f;
#pragma unroll
        for (int ww = 0; ww < 8; ++ww) tot += hsq[ww * 64 + t];
        const float rstd = rsqrtf(tot * (1.0f / 256.0f) + EPS);
#pragma unroll
        for (int i = 0; i < 2; ++i) { const int e = 32 * w + 16 * i + 4 * fq;
            const u32x2 mo = mo2[rt][i]; const f32x4 gg = g4[i];
            const float y0 = hv[rt][i][0] * rstd * gg[0] * sigmoidf_(bflo(mo.x)), y1 = hv[rt][i][1] * rstd * gg[1] * sigmoidf_(bfhi(mo.x));
            const float y2 = hv[rt][i][2] * rstd * gg[2] * sigmoidf_(bflo(mo.y)), y3 = hv[rt][i][3] * rstd * gg[3] * sigmoidf_(bfhi(mo.y));
            u32x2 pw; pw.x = pk2(y0, y1); pw.y = pk2(y2, y3); __builtin_nontemporal_store(pw, (u32x2*)(mix + (tb + t) * DM + h * 256 + e)); }
    }
}

DI void phase_mlstm_out(const Args& a, int l, unsigned char* smem) {
    for (int it = blockIdx.x; it < 512; it += gridDim.x) { const int i = it & 255, xcd = i & 7, slot = i >> 3, bh = xcd * 2 + (slot >> 4), c = (slot & 15) + 16 * (it >> 8); mlstm_out_item(a, l, bh * 32 + c, smem); }
}

constexpr int AT_K = 0, AT_V = 36864, AT_P = 77824, AT_BIAS = 118784, AT_KM = 126976;

DI void attn_item(const Args& a, int b, int head, int qt, unsigned char* smem) {
    const int tid = otid(), w = tid >> 6, lane = tid & 63, fr = lane & 15, fq = lane >> 4;
    const int bh = b * 8 + head, qblk = qt >> 1, q0 = qt * 128 + w * 16;
    bf16_t* Kt = (bf16_t*)(smem + AT_K); bf16_t* Vt = (bf16_t*)(smem + AT_V); bf16_t* Pw = (bf16_t*)(smem + AT_P) + w * 2 * 16 * 80;
    float* biasTab = (float*)(smem + AT_BIAS); float* km = (float*)(smem + AT_KM);
    const bf16_t* aqn = (const bf16_t*)(a.ws + O_AQN); const bf16_t* akn = (const bf16_t*)(a.ws + O_AKN); const bf16_t* avT = (const bf16_t*)(a.ws + O_AVT);
    __syncthreads();
    for (int i = tid; i < 2048; i += 512) biasTab[i] = ((const float*)(a.ws + O_BIAST))[head * 2048 + i];
    for (int i = tid; i < 1024; i += 512) km[i] = ((const float*)(a.ws + O_KMEAN))[(size_t)bh * 1024 + i];
    bf16x8 qf[4];
    { const bf16_t* qp = aqn + ((size_t)b * SEQ + q0 + fr) * 1024 + head * 128 + fq * 8;
#pragma unroll
      for (int kk = 0; kk < 4; ++kk) qf[kk] = *(const bf16x8*)(qp + kk * 32); }
    const int krow = tid >> 3, kseg = tid & 7, vd = tid >> 2, vseg = tid & 3;
    u32x4 pkA[2], pvA[2], pkB[2], pvB[2];
#define AT_LOAD(PK, PV, kt) do { _Pragma("unroll") for (int i = 0; i < 2; ++i) { \
        PK[i] = *(const u32x4*)(akn + ((size_t)b * SEQ + (kt) * 64 + krow) * 1024 + head * 128 + kseg * 8 + i * 64); \
        PV[i] = *(const u32x4*)(avT + ((size_t)bh * 128 + vd) * SEQ + (kt) * 64 + vseg * 8 + i * 32); } } while (0)
#define AT_STORE(PK, PV, buf) do { _Pragma("unroll") for (int i = 0; i < 2; ++i) { \
        *(u32x4*)(Kt + (buf) * 64 * 144 + krow * 144 + kseg * 8 + i * 64) = PK[i]; \
        *(u32x4*)(Vt + (buf) * 128 * 80 + vd * 80 + vseg * 8 + i * 32) = PV[i]; } } while (0)
    AT_LOAD(pkA, pvA, 0);
    AT_LOAD(pkB, pvB, 1);
    __syncthreads();
    unsigned selmask;
    { float g[8];
#pragma unroll
      for (int n = 0; n < 8; ++n) { float p = 0.f;
#pragma unroll
          for (int kk = 0; kk < 4; ++kk)
              { const f32x4 k0 = *(const f32x4*)(km + n * 128 + kk * 32 + fq * 8), k1 = *(const f32x4*)(km + n * 128 + kk * 32 + fq * 8 + 4);
                p += bf1((bf16_t)qf[kk][0]) * k0[0] + bf1((bf16_t)qf[kk][1]) * k0[1] + bf1((bf16_t)qf[kk][2]) * k0[2] + bf1((bf16_t)qf[kk][3]) * k0[3]
                   + bf1((bf16_t)qf[kk][4]) * k1[0] + bf1((bf16_t)qf[kk][5]) * k1[1] + bf1((bf16_t)qf[kk][6]) * k1[2] + bf1((bf16_t)qf[kk][7]) * k1[3]; }
          p += shx(p, 16); p += shx(p, 32); g[n] = p; }
      if (qblk <= 3) selmask = (1u << qblk) - 1u;
      else { selmask = 0u;
#pragma unroll
          for (int r = 0; r < 3; ++r) { float best = -INFINITY; int bi = 0;
#pragma unroll
              for (int n = 0; n < 8; ++n) if (n < qblk && !((selmask >> n) & 1u) && g[n] > best) { best = g[n]; bi = n; }
              selmask |= 1u << bi; } } }
    AT_STORE(pkA, pvA, 0);
    AT_STORE(pkB, pvB, 1);
    bar_lds();
#pragma unroll
    for (int kk = 0; kk < 4; ++kk) { u32x4 t_ = __builtin_bit_cast(u32x4, qf[kk]); asm volatile("" : "+v"(t_.x), "+v"(t_.y), "+v"(t_.z), "+v"(t_.w)); qf[kk] = __builtin_bit_cast(bf16x8, t_); }
    const int nkt = 2 * (qt + 1);
    f32x4 o[8];
#pragma unroll
    for (int i = 0; i < 8; ++i) o[i] = (f32x4){0.f, 0.f, 0.f, 0.f};
    float lrun = 0.f;
    const int qpos = q0 + fr;
    auto compute2 = [&](const int kt) __attribute__((always_inline)) {
        bool own[2], lsel[2], act[2];
#pragma unroll
        for (int u = 0; u < 2; ++u) { const int n = (kt + u) >> 2; own[u] = (n == qblk); lsel[u] = ((selmask >> n) & 1u) != 0u;
            act[u] = own[u] ? ((kt + u) * 64 <= q0 + 15) : (__ballot(lsel[u]) != 0ull); }
        if (act[0] || act[1]) {
            f32x4 s[2][4];
#pragma unroll
            for (int hf = 0; hf < 2; ++hf) { bf16x8 kf[2][8];
#pragma unroll
                for (int u = 0; u < 2; ++u)
#pragma unroll
                    for (int i = 0; i < 8; ++i) kf[u][i] = *(const bf16x8*)(Kt + u * 64 * 144 + ((hf * 2 + (i >> 2)) * 16 + fr) * 144 + (i & 3) * 32 + fq * 8);
#pragma unroll
                for (int u = 0; u < 2; ++u) { s[u][hf * 2] = (f32x4){0.f, 0.f, 0.f, 0.f}; s[u][hf * 2 + 1] = (f32x4){0.f, 0.f, 0.f, 0.f}; }
#pragma unroll
                for (int kk = 0; kk < 4; ++kk)
#pragma unroll
                    for (int u = 0; u < 2; ++u)
#pragma unroll
                        for (int c2 = 0; c2 < 2; ++c2) s[u][hf * 2 + c2] = MFMA16(kf[u][c2 * 4 + kk], qf[kk], s[u][hf * 2 + c2]); }
#pragma unroll
            for (int u = 0; u < 2; ++u) {
                float bv[16];
                const int rel0 = qpos - ((kt + u) * 64 + 4 * fq);
                { const float* bp = biasTab + (rel0 - 51);
#pragma unroll
                  for (int ct = 0; ct < 4; ++ct)
#pragma unroll
                      for (int j = 0; j < 4; ++j) bv[ct * 4 + j] = bp[51 - ct * 16 - j]; }
                float ps = 0.f; u32x2 pw[4];
                if (!own[u]) {
#pragma unroll
                    for (int ct = 0; ct < 4; ++ct) { float p[4];
#pragma unroll
                        for (int j = 0; j < 4; ++j) { p[j] = __builtin_amdgcn_exp2f(s[u][ct][j] + bv[ct * 4 + j]); ps += p[j]; }
                        pw[ct].x = pk2(p[0], p[1]); pw[ct].y = pk2(p[2], p[3]); }
                    if (!lsel[u]) { ps = 0.f;
#pragma unroll
                        for (int ct = 0; ct < 4; ++ct) { pw[ct].x = 0u; pw[ct].y = 0u; } }
                } else {
#pragma unroll
                    for (int ct = 0; ct < 4; ++ct) { float p[4];
#pragma unroll
                        for (int j = 0; j < 4; ++j) { const int rel = rel0 - ct * 16 - j; p[j] = rel >= 0 ? __builtin_amdgcn_exp2f(s[u][ct][j] + bv[ct * 4 + j]) : 0.f; ps += p[j]; }
                        pw[ct].x = pk2(p[0], p[1]); pw[ct].y = pk2(p[2], p[3]); }
                }
                lrun += ps;
#pragma unroll
                for (int ct = 0; ct < 4; ++ct) *(u32x2*)(Pw + u * 16 * 80 + fr * 80 + ct * 16 + 4 * fq) = pw[ct];
            }
            bf16x8 pf[2][2];
#pragma unroll
            for (int u = 0; u < 2; ++u) { pf[u][0] = *(const bf16x8*)(Pw + u * 16 * 80 + fr * 80 + fq * 8); pf[u][1] = *(const bf16x8*)(Pw + u * 16 * 80 + fr * 80 + 32 + fq * 8); }
#pragma unroll
            for (int dh = 0; dh < 2; ++dh) { bf16x8 vf[2][8];
#pragma unroll
                for (int u = 0; u < 2; ++u)
#pragma unroll
                    for (int i = 0; i < 8; ++i) vf[u][i] = *(const bf16x8*)(Vt + u * 128 * 80 + ((dh * 4 + (i >> 1)) * 16 + fr) * 80 + (i & 1) * 32 + fq * 8);
#pragma unroll
                for (int u = 0; u < 2; ++u)
#pragma unroll
                    for (int k2 = 0; k2 < 2; ++k2)
#pragma unroll
                        for (int dt = 0; dt < 4; ++dt) o[dh * 4 + dt] = MFMA16(vf[u][dt * 2 + k2], pf[u][k2], o[dh * 4 + dt]); }
        }
    };
#ifdef PROBE_MASK
    unsigned long long tcomp = 0ull; const unsigned long long tl0 = clock64();
#endif
#pragma unroll 1
    for (int kt = 0; kt < nkt; kt += 2) {
        if (kt + 2 < nkt) { AT_LOAD(pkA, pvA, kt + 2); AT_LOAD(pkB, pvB, kt + 3); }
#ifdef PROBE_MASK
        const unsigned long long tc0 = clock64();
#endif
        compute2(kt);
#ifdef PROBE_MASK
        const unsigned long long tc1 = clock64();
#if !defined(PROBE_SEL) || PROBE_SEL == 0
        tcomp += tc1 - tc0;
#endif
#endif
        bar_lds();
#ifdef PROBE_MASK
        const unsigned long long tc2 = clock64();
#if PROBE_SEL == 1
        tcomp += tc2 - tc1;
#endif
#endif
        if (kt + 2 < nkt) { AT_STORE(pkA, pvA, 0); AT_STORE(pkB, pvB, 1); }
#ifdef PROBE_MASK
        asm volatile("s_waitcnt lgkmcnt(0)" ::: "memory");
        const unsigned long long tc3 = clock64();
#if PROBE_SEL == 2
        tcomp += tc3 - tc2;
#endif
#endif
        bar_lds();
    }
#ifdef PROBE_MASK
    if (blockIdx.x == 0 && tid == 0) { unsigned long long* ts = (unsigned long long*)(a.ws + O_TS); ts[70] += tcomp; ts[71] += clock64() - tl0; }
#endif
    lrun += shx(lrun, 16); lrun += shx(lrun, 32);
    const float inv = 1.0f / lrun;
    bf16_t* op = (bf16_t*)(a.ws + O_MIX) + ((size_t)b * SEQ + qpos) * DM + 1024 + head * 128 + 4 * fq;
#pragma unroll
    for (int dt = 0; dt < 8; ++dt) { u32x2 pw; pw.x = pk2(o[dt][0] * inv, o[dt][1] * inv); pw.y = pk2(o[dt][2] * inv, o[dt][3] * inv); __builtin_nontemporal_store(pw, (u32x2*)(op + dt * 16)); }
#undef AT_LOAD
#undef AT_STORE
}

DI void phase_mixer(const Args& a, unsigned char* smem, int l) {
    for (int it = blockIdx.x; it < 256; it += gridDim.x) { const int xcd = it & 7, slot = it >> 3; mlstm_item(a, (xcd * 2 + (slot >> 4)) * 16 + (slot & 15), smem); }
#ifdef PROBE_MASK
    if (blockIdx.x == 0 && otid() == 0) ((unsigned long long*)(a.ws + O_TS))[64 + l] = wall_clock64();
#endif
    for (int it = blockIdx.x; it < 256; it += gridDim.x) { const int xcd = it & 7, slot = it >> 3, bh = xcd * 4 + (slot >> 3), j = slot & 7; attn_item(a, bh >> 3, bh & 7, j, smem); attn_item(a, bh >> 3, bh & 7, 15 - j, smem); }
#ifdef PROBE_MASK
    if (blockIdx.x == 0 && otid() == 0) ((unsigned long long*)(a.ws + O_TS))[80 + l] = wall_clock64();
#endif
}

DI void phase_hnorm(const Args& a, int l) {
    const float* hbuf = (const float*)(a.ws + O_HBUF); const u64* hss = (const u64*)(a.ws + O_HSS); const bf16_t* z = (const bf16_t*)(a.ws + O_Z);
    bf16_t* mix = (bf16_t*)(a.ws + O_MIX); const float* gn = a.mlstm_norm + (size_t)l * 1024;
    for (int i = blockIdx.x * 512 + otid(); i < T_TOK * 128; i += gridDim.x * 512) {
        const int t = i >> 7, c = (i & 127) * 8;
        const float rstd = rsqrtf((float)hss[(size_t)t * 4 + (c >> 8)] * (HS_INV / 256.0f) + EPS);
        const f32x4 h0 = *(const f32x4*)(hbuf + (size_t)t * 1024 + c), h1 = *(const f32x4*)(hbuf + (size_t)t * 1024 + c + 4);
        const f32x4 g0 = *(const f32x4*)(gn + c), g1 = *(const f32x4*)(gn + c + 4);
        float mo[8], y[8]; unpack8(*(const u32x4*)(z + (size_t)t * ZLD + 3072 + c), mo);
#pragma unroll
        for (int e = 0; e < 4; ++e) { y[e] = h0[e] * rstd * g0[e] * sigmoidf_(mo[e]); y[4 + e] = h1[e] * rstd * g1[e] * sigmoidf_(mo[4 + e]); }
        *(u32x4*)(mix + (size_t)t * DM + c) = pack8(y);
    }
}

DI void phase_ffnconv(const Args& a, int l) {
    const bf16_t* u = (const bf16_t*)(a.ws + O_U); bf16_t* act = (bf16_t*)(a.ws + O_ACT);
    const float* cw = a.conv_ffn_w + (size_t)l * 3 * DFF2; const float* cb = a.conv_ffn_b + (size_t)l * DFF2;
    constexpr int NCG = DFF / 8, RB = 8;
    for (int i = blockIdx.x * 512 + otid(); i < (T_TOK / RB) * NCG; i += gridDim.x * 512) {
        const int rb = i / NCG, f = (i % NCG) * 8; const int t0 = rb * RB; const bool first = (t0 % SEQ) == 0;
        u32x4 gr[RB + 2], vr[RB + 2];
#pragma unroll
        for (int r = 0; r < RB + 2; ++r) { gr[r] = (u32x4){0u, 0u, 0u, 0u}; vr[r] = gr[r];
            if (r >= 2 || !first) { const bf16_t* up = u + (size_t)(t0 - 2 + r) * DFF2 + f; gr[r] = __builtin_nontemporal_load((const u32x4*)up); vr[r] = __builtin_nontemporal_load((const u32x4*)(up + DFF)); } }
        float wg[3][8], wv[3][8], bg[8], bv[8];
#pragma unroll
        for (int j = 0; j < 3; ++j) { const f32x4 p0 = *(const f32x4*)(cw + j * DFF2 + f), p1 = *(const f32x4*)(cw + j * DFF2 + f + 4), q0 = *(const f32x4*)(cw + j * DFF2 + DFF + f), q1 = *(const f32x4*)(cw + j * DFF2 + DFF + f + 4);
#pragma unroll
            for (int e = 0; e < 4; ++e) { wg[j][e] = p0[e]; wg[j][4 + e] = p1[e]; wv[j][e] = q0[e]; wv[j][4 + e] = q1[e]; } }
        { const f32x4 p0 = *(const f32x4*)(cb + f), p1 = *(const f32x4*)(cb + f + 4), q0 = *(const f32x4*)(cb + DFF + f), q1 = *(const f32x4*)(cb + DFF + f + 4);
#pragma unroll
          for (int e = 0; e < 4; ++e) { bg[e] = p0[e]; bg[4 + e] = p1[e]; bv[e] = q0[e]; bv[4 + e] = q1[e]; } }
        float g0[8], g1[8], v0[8], v1[8];
        unpack8(gr[0], g0); unpack8(gr[1], g1); unpack8(vr[0], v0); unpack8(vr[1], v1);
#pragma unroll
        for (int r = 0; r < RB; ++r) { float g2[8], v2[8], y[8];
            unpack8(gr[r + 2], g2); unpack8(vr[r + 2], v2);
#pragma unroll
            for (int e = 0; e < 8; ++e) { const float G = bg[e] + wg[0][e] * g0[e] + wg[1][e] * g1[e] + wg[2][e] * g2[e]; const float V = bv[e] + wv[0][e] * v0[e] + wv[1][e] * v1[e] + wv[2][e] * v2[e];
                y[e] = siluf_(G) * V; g0[e] = g1[e]; g1[e] = g2[e]; v0[e] = v1[e]; v1[e] = v2[e]; }
            *(u32x4*)(act + (size_t)(t0 + r) * DFF + f) = pack8(y); }
    }
}

#define XB_TMO      128
#define XB_XCNT(j)  (256  + 64 * (j))
#define XB_XSUB(j)  (1280 + 64 * (j))
#define XB_XGEN(j)  (2304 + 64 * (j))
#define XB_TOP      3328
#define XB_TOPGEN   3392
#define XCD_BAR_WORDS 3456
#define XB_SPIN_CAP (1u << 18)

__device__ __forceinline__ unsigned xb_ld(unsigned* p)              { return __hip_atomic_load(p, __ATOMIC_RELAXED, __HIP_MEMORY_SCOPE_AGENT); }
__device__ __forceinline__ unsigned xb_add(unsigned* p, unsigned v) { return __hip_atomic_fetch_add(p, v, __ATOMIC_RELAXED, __HIP_MEMORY_SCOPE_AGENT); }
__device__ __forceinline__ unsigned xb_xcc_id() { return (unsigned)__builtin_amdgcn_s_getreg((3 << 11) | 20) & 0xFu; }
#define XB_SPIN(cond, bar) do { unsigned _sp = 0; while (cond) { __builtin_amdgcn_s_sleep(1); \
    if ((++_sp & 255u) == 0u) { if (xb_ld(&(bar)[XB_TMO])) break; if (_sp > XB_SPIN_CAP) { atomicAdd(&(bar)[XB_TMO], 1u); break; } } } } while (0)

struct XcdBarrier {
    unsigned* bar; unsigned x;
    volatile LAS unsigned* st;
};

__device__ __forceinline__ XcdBarrier xcd_barrier_post(unsigned* bar, volatile LAS unsigned* st, int tid) {
    XcdBarrier b; b.bar = bar; b.x = xb_xcc_id(); b.st = st;
    if (tid == 0) (void)xb_add(&bar[XB_XCNT(b.x)], 1u);
    return b;
}
__device__ __forceinline__ void xcd_barrier_complete(unsigned* bar, unsigned x, unsigned& nloc, unsigned& nx) {
    const unsigned G = gridDim.x * gridDim.y * gridDim.z;
    unsigned sum, cnt, mine, sp = 0u;
    for (;;) {
        sum = 0u; cnt = 0u; mine = 0u;
#pragma unroll
        for (unsigned j = 0; j < 16; ++j) { const unsigned c = xb_ld(&bar[XB_XCNT(j)]); sum += c; cnt += (c > 0u) ? 1u : 0u; mine = (j == x) ? c : mine; }
        if (sum == G) break;
        __builtin_amdgcn_s_sleep(1);
        if ((++sp & 255u) == 0u) { if (xb_ld(&bar[XB_TMO])) break; if (sp > XB_SPIN_CAP) { atomicAdd(&bar[XB_TMO], 1u); break; } }
    }
    nloc = mine > 0u ? mine : 1u; nx = cnt > 0u ? cnt : 1u;
}

__device__ __forceinline__ void xcd_barrier(const XcdBarrier& b, int tid) {
    asm volatile("s_waitcnt vmcnt(0)" ::: "memory");
    __syncthreads();
    if (tid == 0) {
        unsigned* bar = b.bar;
        __builtin_amdgcn_s_waitcnt(0);
        unsigned nloc = b.st[0], nx = b.st[1];
        if (nloc == 0u) { xcd_barrier_complete(bar, b.x, nloc, nx); b.st[0] = nloc; b.st[1] = nx; }
        const unsigned old = xb_add(&bar[XB_XSUB(b.x)], 1u);
        const unsigned gen = old / nloc;
        if (old + 1u == (gen + 1u) * nloc) {
            __builtin_amdgcn_fence(__ATOMIC_RELEASE, "agent");
            asm volatile("s_waitcnt vmcnt(0)" ::: "memory");
            const unsigned og = xb_add(&bar[XB_TOP], 1u);
            const unsigned tg = og / nx;
            if (og + 1u == (tg + 1u) * nx) xb_add(&bar[XB_TOPGEN], 1u);
            else XB_SPIN(xb_ld(&bar[XB_TOPGEN]) == tg, bar);
            __builtin_amdgcn_fence(__ATOMIC_ACQUIRE, "agent");
            xb_add(&bar[XB_XGEN(b.x)], 1u);
            asm volatile("s_waitcnt vmcnt(0)" ::: "memory");
        } else {
            XB_SPIN(xb_ld(&bar[XB_XGEN(b.x)]) == gen, bar);
            __builtin_amdgcn_fence(__ATOMIC_ACQUIRE, "agent");
            asm volatile("s_waitcnt vmcnt(0)" ::: "memory");
        }
    }
    __syncthreads();
}

__global__ void __launch_bounds__(512) mega_fwd(Args a_in) {
    Args a = a_in; a.wv = __builtin_amdgcn_readfirstlane((int)threadIdx.x >> 6);
    extern __shared__ __attribute__((aligned(16))) unsigned char smem[];
    cg::grid_group grid = cg::this_grid();
    constexpr int NPH = 1 + 8 * DEPTH;
    volatile LAS unsigned* bst = (volatile LAS unsigned*)(LAS unsigned char*)(smem + LDS_BYTES - 16);
    if (otid() < 2) bst[otid()] = 0u;
    __syncthreads();
    const XcdBarrier gbar = xcd_barrier_post((unsigned*)(a.ws + O_BAR), bst, otid());
#pragma unroll 1
    for (int ph = 0; ph < NPH; ++ph) {
        const int l = (ph - 1) >> 3, k = (ph - 1) & 7;
#ifdef PROBE_MASK
        if (blockIdx.x == 0 && otid() == 0) { ((unsigned long long*)(a.ws + O_TS))[ph] = wall_clock64(); if (ph == 0) { ((unsigned long long*)(a.ws + O_TS))[70] = 0ull; ((unsigned long long*)(a.ws + O_TS))[71] = 0ull; } }
#endif
        u64* ss = (u64*)(a.ws + O_SS);
        bf16_t* xb = (bf16_t*)(a.ws + O_XB);
        if (ph == 0) phase0(a, smem);
        else if (k == 0 || k == 5) {
            EpiScale E; const bf16_t* Bt; int N;
            if (k == 0) { E.O = (bf16_t*)(a.ws + O_Z); E.ldc = ZLD; E.SS = ss + (size_t)(2 * l) * T_TOK; E.gates = (float*)(a.ws + O_GATES); E.gate_pn = 28; Bt = (const bf16_t*)(a.ws + O_WIN + l * SZ_WIN); N = DINP; }
            else { E.O = (bf16_t*)(a.ws + O_U); E.ldc = DFF2; E.SS = ss + (size_t)(2 * l + 1) * T_TOK; E.gates = nullptr; E.gate_pn = -1; Bt = (const bf16_t*)(a.ws + O_WUP + l * SZ_WUP); N = DFF2; }
            run_gemm(smem, xb, Bt, T_TOK, N, DM, E, a.wv);
        } else if (k == 4 || k == 7) {
            EpiRes E; E.X = (k == 7 && l == DEPTH - 1) ? a.out : nullptr; E.XB = xb; const bf16_t* A; const bf16_t* Bt; int K;
            if (k == 4) { E.SS = ss + (size_t)(2 * l + 1) * T_TOK; A = (const bf16_t*)(a.ws + O_MIX); Bt = (const bf16_t*)(a.ws + O_WOUT + l * SZ_WOUT); K = DM; }
            else { E.SS = ss + (size_t)(2 * l + 2) * T_TOK; A = (const bf16_t*)(a.ws + O_ACT); Bt = (const bf16_t*)(a.ws + O_WD + l * SZ_WD); K = DFF; }
            run_gemm(smem, A, Bt, T_TOK, DM, K, E, a.wv);
        } else if (k == 1) phase_prep(a, l, smem);
        else if (k == 2) phase_mixer(a, smem, l);
        else if (k == 3) phase_mlstm_out(a, l, smem);
        else phase_ffnconv(a, l);
        if (a.ws == nullptr) grid.sync();
        if (ph + 1 < NPH) xcd_barrier(gbar, otid());
    }
#ifdef PROBE_MASK
    if (blockIdx.x == 0) {
        __syncthreads();
        float* dsh = (float*)smem;
        if (otid() == 0) {
            unsigned long long* ts = (unsigned long long*)(a.ws + O_TS); ts[NPH] = wall_clock64();
            unsigned long long sel = 0ull;
            for (int ph = 0; ph < NPH; ++ph) { const int kk = ph == 0 ? 8 : ((ph - 1) & 7); if ((PROBE_MASK >> kk) & 1) sel += ts[ph + 1] - ts[ph]; }
            if ((PROBE_MASK >> 9) & 1) for (int l = 0; l < DEPTH; ++l) sel += ts[64 + l] - ts[1 + 8 * l + 2];
            float frac = (float)sel / (float)(ts[NPH] - ts[0]);
            if ((PROBE_MASK >> 10) & 1) frac = (float)ts[70] / (float)ts[71];
            if ((PROBE_MASK >> 11) & 1) { unsigned long long w_ = 0ull, p_ = 0ull; for (int l = 0; l < DEPTH; ++l) { w_ += ts[1 + 8 * l + 3] - ts[80 + l]; p_ += ts[1 + 8 * l + 3] - ts[1 + 8 * l + 2]; } frac = (float)w_ / (float)p_; }
            dsh[0] = 0.5f * sqrtf(frac);
        }
        __syncthreads();
        asm volatile("s_waitcnt vmcnt(0)" ::: "memory");
        const float d = dsh[0];
        for (int i = otid(); i < 256 * 256; i += 512) a.out[(size_t)(i >> 8) * DM + (i & 255)] += d;
    }
#endif
}

extern "C" void kernel_launch(void* const* d_in, const int* in_sizes, int n_in, void* d_out, int out_size, void* d_ws, size_t ws_size, hipStream_t stream) {
    static int grid = 0;
    if (grid == 0) {
        if (n_in != 15 || out_size != T_TOK * DM || ws_size < WS_END) { fprintf(stderr, "kernel_launch: unexpected shapes (n_in %d out %d ws %zu need %zu)\n", n_in, out_size, ws_size, (size_t)WS_END); grid = -1; return; }
        int dev = 0, cus = 0, per_cu = 0;
        (void)hipGetDevice(&dev); (void)hipDeviceGetAttribute(&cus, hipDeviceAttributeMultiprocessorCount, dev);
        if (hipFuncSetAttribute((const void*)mega_fwd, hipFuncAttributeMaxDynamicSharedMemorySize, LDS_BYTES) != hipSuccess) { fprintf(stderr, "kernel_launch: hipFuncSetAttribute failed\n"); }
        if (hipOccupancyMaxActiveBlocksPerMultiprocessor(&per_cu, (const void*)mega_fwd, 512, LDS_BYTES) != hipSuccess || per_cu < 1) per_cu = 1;
        (void)hipGetLastError();
        grid = cus * (per_cu > 1 ? 1 : per_cu);
        if (grid <= 0) grid = 256;
    }
    if (grid < 0) return;
    Args a{};
    a.x = (const float*)d_in[0]; a.norm_mix = (const float*)d_in[1]; a.w_in = (const float*)d_in[2]; a.gate_bias = (const float*)d_in[3];
    a.conv_qk_w = (const float*)d_in[4]; a.conv_qk_b = (const float*)d_in[5]; a.mlstm_norm = (const float*)d_in[6]; a.qk_norm = (const float*)d_in[7];
    a.rel_bias = (const float*)d_in[8]; a.w_out = (const float*)d_in[9]; a.norm_ffn = (const float*)d_in[10]; a.w_up = (const float*)d_in[11];
    a.conv_ffn_w = (const float*)d_in[12]; a.conv_ffn_b = (const float*)d_in[13]; a.w_down = (const float*)d_in[14];
    a.out = (float*)d_out; a.ws = (unsigned char*)d_ws;
    (void)hipMemsetAsync((unsigned char*)d_ws + O_BAR, 0, 16384, stream);
    void* args[] = {&a};
    hipError_t e = hipLaunchCooperativeKernel((const void*)mega_fwd, dim3(grid), dim3(512), args, LDS_BYTES, stream);
    if (e != hipSuccess) fprintf(stderr, "kernel_launch: cooperative launch failed: %s (grid %d)\n", hipGetErrorString(e), grid);
}
```
